# Optimizing an MI355X kernel written in HIP

```python
import math
import jax, jax.numpy as jnp
from jax import lax
import numpy as np

D_MODEL = 1024
BATCH = 8
SEQ = 4096
DEPTH = 4

MLA_HEADS = 8
MLA_Q_RANK = 256
MLA_KV_RANK = 128
MLA_NOPE = 64
MLA_ROPE = 32
MLA_V = 64
ROPE_BASE = 10000.0
DIL_PATTERNS = ((128, 1), (512, 4), (2048, 16))
DIL_GROUPS = 3
DIL_HEADS = 4
DIL_QK = 64
DIL_V = 128
DIFF_HEADS = 4
DIFF_QK = 64
DIFF_V = 2 * DIFF_QK
REL_BUCKETS = 32
REL_MAX_DIST = 128
DIL_BIAS_COLS = DIL_GROUPS * DIL_HEADS
N_BIAS = DIL_BIAS_COLS + 2 * DIFF_HEADS
N_BRANCH = 3
BRANCH_W = 512
D_FF = 4 * D_MODEL
Q_BLOCK = 128
EPS = 1e-6
NEG = -1e30

COL_SIZES = (
    MLA_Q_RANK, MLA_KV_RANK, MLA_ROPE,
    DIL_GROUPS * DIL_HEADS * DIL_QK, DIL_GROUPS * DIL_HEADS * DIL_QK, DIL_HEADS * DIL_V,
    2 * DIFF_HEADS * DIFF_QK, 2 * DIFF_HEADS * DIFF_QK, DIFF_HEADS * DIFF_V,
    N_BRANCH * D_MODEL,
)
IN_COLS = sum(COL_SIZES)
COL_SPLITS = tuple(int(v) for v in np.cumsum(COL_SIZES)[:-1])

kernel_name = 'hybrid_mla_dilated_diff_gated_encoder'

f32 = jnp.float32


def _rmsnorm(x, g):
    x32 = x.astype(f32)
    y = x32 * lax.rsqrt(jnp.mean(x32 * x32, axis=-1, keepdims=True) + EPS)
    return (y * g.astype(f32)).astype(x.dtype)


def _rope(x, pos):
    half = x.shape[-1] // 2
    inv = ROPE_BASE ** (-jnp.arange(half, dtype=f32) / half)
    ang = pos.astype(f32)[:, :, None] * inv
    cos = jnp.cos(ang)[:, :, None, :]
    sin = jnp.sin(ang)[:, :, None, :]
    x32 = x.astype(f32)
    x1, x2 = x32[..., :half], x32[..., half:]
    return jnp.concatenate([x1 * cos - x2 * sin, x2 * cos + x1 * sin], axis=-1).astype(x.dtype)


def _rel_bucket(rel):
    nb = REL_BUCKETS // 2
    max_exact = nb // 2
    ret = jnp.where(rel > 0, nb, 0)
    n = jnp.abs(rel)
    large = max_exact + (jnp.log(jnp.maximum(n, 1).astype(f32) / max_exact)
                         / math.log(REL_MAX_DIST / max_exact) * (nb - max_exact)).astype(jnp.int32)
    large = jnp.minimum(large, nb - 1)
    return ret + jnp.where(n < max_exact, n, large)


def _to_blocks(x):
    b, s = x.shape[:2]
    x = x.reshape((b, s // Q_BLOCK, Q_BLOCK) + x.shape[2:])
    return jnp.moveaxis(x, 1, 0)


def _from_blocks(y):
    y = jnp.moveaxis(y, 0, 1)
    return y.reshape((y.shape[0], y.shape[1] * y.shape[2]) + y.shape[3:])


def _mla(c_q, c_kv, k_r, pos, w_uq, g_q, w_ukv, g_kv):
    q = jnp.einsum('bsr,rhd->bshd', _rmsnorm(c_q, g_q), w_uq)
    kv = jnp.einsum('bsr,rhd->bshd', _rmsnorm(c_kv, g_kv), w_ukv)
    q = jnp.concatenate([q[..., :MLA_NOPE], _rope(q[..., MLA_NOPE:], pos)], axis=-1)
    k_rope = _rope(k_r[:, :, None, :], pos)
    k = jnp.concatenate([kv[..., :MLA_NOPE],
                         jnp.broadcast_to(k_rope, kv.shape[:3] + (MLA_ROPE,))], axis=-1)
    v = kv[..., MLA_NOPE:]
    scale = (MLA_NOPE + MLA_ROPE) ** -0.5

    def block(qb):
        s = jnp.einsum('bqhd,bkhd->bhqk', qb, k).astype(f32) * scale
        p = jax.nn.softmax(s, axis=-1).astype(v.dtype)
        return jnp.einsum('bhqk,bkhd->bqhd', p, v)

    o = _from_blocks(lax.map(block, _to_blocks(q)))
    return o.reshape(o.shape[:2] + (MLA_HEADS * MLA_V,))


def _dilated_group(q, k, v, tab_g, window, dil):
    b, n_seq, h, _ = q.shape
    half = window // (2 * dil)
    bs = half
    L = n_seq // dil
    nblk = -(-L // bs)
    Lp = nblk * bs

    def strided(x, lo, hi):
        x = jnp.swapaxes(x.reshape((b, L, dil) + x.shape[2:]), 1, 2)
        return jnp.pad(x, ((0, 0), (0, 0), (lo, hi), (0, 0), (0, 0)))

    def bands(x):
        xs = strided(x, bs, Lp - L + bs).reshape((b, dil, nblk + 2, bs) + x.shape[2:])
        return jnp.concatenate([xs[:, :, :-2], xs[:, :, 1:-1], xs[:, :, 2:]], axis=3)

    qs = strided(q, 0, Lp - L).reshape((b, dil, nblk, bs) + q.shape[2:])
    kb = bands(k)
    vb = bands(v)
    qi = jnp.arange(bs)[:, None]
    kj = jnp.arange(3 * bs)[None, :] - bs
    rel = kj - qi
    kidx = jnp.arange(nblk)[:, None, None] * bs + kj[None]
    mask = (jnp.abs(rel) <= half)[None] & (kidx >= 0) & (kidx < L)
    bias = jnp.transpose(tab_g.astype(f32)[_rel_bucket(rel * dil)], (2, 0, 1))
    s = jnp.einsum('brnqhd,brnkhd->brnhqk', qs, kb).astype(f32) * (DIL_QK ** -0.5) + bias
    s = jnp.where(mask[None, None, :, None], s, NEG)
    lse = jax.nn.logsumexp(s, axis=-1)
    p = jnp.exp(s - lse[..., None]).astype(v.dtype)
    o = jnp.einsum('brnhqk,brnkhd->brnqhd', p, vb)

    def unstrided(y):
        y = y.reshape((b, dil, Lp) + y.shape[4:])[:, :, :L]
        return jnp.swapaxes(y, 1, 2).reshape((b, n_seq) + y.shape[3:])

    return unstrided(o), unstrided(jnp.swapaxes(lse, 3, 4)[..., None])[..., 0]


def _dilated(q, k, v, bias_tab):
    outs, lses = [], []
    for g in range(DIL_GROUPS):
        window, dil = DIL_PATTERNS[g]
        o, l = _dilated_group(q[:, :, g], k[:, :, g], v,
                              bias_tab[:, g * DIL_HEADS:(g + 1) * DIL_HEADS], window, dil)
        outs.append(o)
        lses.append(l)
    alpha = jax.nn.softmax(jnp.stack(lses, axis=0), axis=0)
    o = jnp.einsum('gbsh,gbshd->bshd', alpha, jnp.stack(outs, axis=0).astype(f32)).astype(v.dtype)
    return o.reshape(o.shape[:2] + (DIL_HEADS * DIL_V,))


def _diff(q, k, v, pos, bias_tab, lq1, lk1, lq2, lk2, g_sub, layer):
    lam_init = 0.8 - 0.6 * math.exp(-0.3 * layer)
    lam = (jnp.exp(jnp.sum(lq1.astype(f32) * lk1.astype(f32)))
           - jnp.exp(jnp.sum(lq2.astype(f32) * lk2.astype(f32))) + lam_init)
    tab = bias_tab[:, DIL_BIAS_COLS:].astype(f32).reshape(REL_BUCKETS, 2, DIFF_HEADS)
    scale = DIFF_QK ** -0.5

    def block(args):
        qb, pb = args
        s = jnp.einsum('bqmhd,bkmhd->bmhqk', qb, k).astype(f32) * scale
        rel = pos[:, None, :] - pb[:, :, None]
        s = s + jnp.transpose(tab[_rel_bucket(rel)], (0, 3, 4, 1, 2))
        p = jax.nn.softmax(s, axis=-1)
        w = (p[:, 0] - lam * p[:, 1]).astype(v.dtype)
        return jnp.einsum('bhqk,bkhd->bqhd', w, v)

    o = _from_blocks(lax.map(block, (_to_blocks(q), _to_blocks(pos))))
    o = (_rmsnorm(o, g_sub).astype(f32) * (1.0 - lam_init)).astype(v.dtype)
    return o.reshape(o.shape[:2] + (DIFF_HEADS * DIFF_V,))


def setup_inputs(seed: int = 0) -> dict:
    key = jax.random.key(seed)
    ks = jax.random.split(key, 24)

    def nrm(k, shape, scale):
        return jax.random.normal(k, shape, dtype=f32) * scale

    def gain(k, shape):
        return 1.0 + 0.05 * jax.random.normal(k, shape, dtype=f32)

    positions = jnp.broadcast_to(jnp.arange(SEQ, dtype=jnp.int32)[None, :], (BATCH, SEQ))
    return {
        'x': nrm(ks[0], (BATCH, SEQ, D_MODEL), 1.0),
        'positions': positions,
        'rel_bias': nrm(ks[1], (REL_BUCKETS, N_BIAS), 0.3),
        'g_mix_pre': gain(ks[2], (DEPTH, D_MODEL)),
        'w_in': nrm(ks[3], (DEPTH, D_MODEL, IN_COLS), D_MODEL ** -0.5),
        'g_q': gain(ks[4], (DEPTH, MLA_Q_RANK)),
        'w_uq': nrm(ks[5], (DEPTH, MLA_Q_RANK, MLA_HEADS, MLA_NOPE + MLA_ROPE), MLA_Q_RANK ** -0.5),
        'g_kv': gain(ks[6], (DEPTH, MLA_KV_RANK)),
        'w_ukv': nrm(ks[7], (DEPTH, MLA_KV_RANK, MLA_HEADS, MLA_NOPE + MLA_V), MLA_KV_RANK ** -0.5),
        'lam_q1': nrm(ks[8], (DEPTH, DIFF_QK), 0.1),
        'lam_k1': nrm(ks[9], (DEPTH, DIFF_QK), 0.1),
        'lam_q2': nrm(ks[10], (DEPTH, DIFF_QK), 0.1),
        'lam_k2': nrm(ks[11], (DEPTH, DIFF_QK), 0.1),
        'g_diff_sub': gain(ks[12], (DEPTH, DIFF_V)),
        'w_branch': nrm(ks[13], (DEPTH, N_BRANCH, BRANCH_W, D_MODEL), BRANCH_W ** -0.5),
        'w_out': nrm(ks[14], (DEPTH, D_MODEL, D_MODEL), D_MODEL ** -0.5),
        'g_mix_post': gain(ks[15], (DEPTH, D_MODEL)),
        'g_mlp_pre': gain(ks[16], (DEPTH, D_MODEL)),
        'w_up': nrm(ks[17], (DEPTH, D_MODEL, D_FF), D_MODEL ** -0.5),
        'w_down': nrm(ks[18], (DEPTH, D_FF, D_MODEL), D_FF ** -0.5),
        'g_mlp_post': gain(ks[19], (DEPTH, D_MODEL)),
    }


def reference(x, positions, rel_bias, g_mix_pre, w_in, g_q, w_uq, g_kv, w_ukv,
              lam_q1, lam_k1, lam_q2, lam_k2, g_diff_sub, w_branch, w_out, g_mix_post,
              g_mlp_pre, w_up, w_down, g_mlp_post):
    b, s, _ = x.shape
    for l in range(DEPTH):
        h = _rmsnorm(x, g_mix_pre[l])
        z = h @ w_in[l]
        (c_q, c_kv, k_r, dq, dk, dv, fq, fk, fv, gz) = jnp.split(z, COL_SPLITS, axis=-1)
        o_a = _mla(c_q, c_kv, k_r, positions, w_uq[l], g_q[l], w_ukv[l], g_kv[l])
        o_b = _dilated(dq.reshape(b, s, DIL_GROUPS, DIL_HEADS, DIL_QK),
                       dk.reshape(b, s, DIL_GROUPS, DIL_HEADS, DIL_QK),
                       dv.reshape(b, s, DIL_HEADS, DIL_V), rel_bias)
        o_c = _diff(fq.reshape(b, s, 2, DIFF_HEADS, DIFF_QK),
                    fk.reshape(b, s, 2, DIFF_HEADS, DIFF_QK),
                    fv.reshape(b, s, DIFF_HEADS, DIFF_V), positions, rel_bias,
                    lam_q1[l], lam_k1[l], lam_q2[l], lam_k2[l], g_diff_sub[l], l)
        gates = jax.nn.sigmoid(gz.astype(f32)).astype(x.dtype).reshape(b, s, N_BRANCH, D_MODEL)
        merged = (gates[:, :, 0] * (o_a @ w_branch[l, 0])
                  + gates[:, :, 1] * (o_b @ w_branch[l, 1])
                  + gates[:, :, 2] * (o_c @ w_branch[l, 2]))
        x = x + _rmsnorm(merged @ w_out[l], g_mix_post[l])
        h2 = _rmsnorm(x, g_mlp_pre[l])
        f = jnp.square(jax.nn.relu(h2 @ w_up[l])) @ w_down[l]
        x = x + _rmsnorm(f, g_mlp_post[l])
    return x
```

```cpp
#include <hip/hip_runtime.h>
#include <hip/hip_cooperative_groups.h>
#include <cstdio>
#include <cstdint>
#include <cmath>
namespace cg = cooperative_groups;

#define LAS __attribute__((address_space(3)))
typedef float f32x2 __attribute__((ext_vector_type(2)));
typedef float f32x16 __attribute__((ext_vector_type(16)));
typedef unsigned u32x2 __attribute__((ext_vector_type(2)));
typedef short s16x4 __attribute__((ext_vector_type(4)));
typedef __bf16 bf16x2_t __attribute__((ext_vector_type(2)));
__device__ __forceinline__ unsigned pk2(float lo, float hi) { f32x2 v = {lo, hi}; bf16x2_t b = __builtin_convertvector(v, bf16x2_t); return __builtin_bit_cast(unsigned, b); }
__device__ __forceinline__ float bflo(unsigned w) { return __uint_as_float(w << 16); }
__device__ __forceinline__ float bfhi(unsigned w) { return __uint_as_float(w & 0xffff0000u); }
__device__ __forceinline__ float wave_sum(float v) {
#pragma unroll
    for (int o = 1; o < 64; o <<= 1) v += __shfl_xor(v, o);
    return v;
}

constexpr int DM = 1024, SEQ = 4096, BATCH = 8, DEPTH = 4, MALL = BATCH * SEQ, CB = 4, MC = CB * SEQ, NCHUNK = 2;
constexpr int NZ = 7168, FF = 4096, INC = 7072;
constexpr float EPS = 1e-6f, LOG2E = 1.4426950408889634f;
constexpr size_t MiB = 1u << 20;
constexpr size_t WS_SSQ = 1 * MiB, WS_SSKV = 1 * MiB + 512 * 1024, WS_SSY = 2 * MiB, WS_LSE = 3 * MiB, WS_TMM = 3 * MiB + 800 * 1024;
constexpr size_t WS_ROPE = 4 * MiB;
constexpr size_t WS_WIN = 8 * MiB, WS_WUQ = 22 * MiB, WS_WUKV = 22 * MiB + 512 * 1024, WS_WBR = 23 * MiB, WS_WOUT = 26 * MiB, WS_WUP = 28 * MiB, WS_WDN = 36 * MiB;
constexpr size_t WS_XN = 44 * MiB;
constexpr size_t WS_G = 108 * MiB;
constexpr size_t WS_CQ = 204 * MiB, WS_CKV = 212 * MiB, WS_KR = 216 * MiB;
constexpr size_t WS_DQ = 218 * MiB, WS_DK = 242 * MiB, WS_DV = 266 * MiB, WS_FQ = 282 * MiB, WS_FK = 298 * MiB, WS_FV = 314 * MiB;
constexpr size_t WS_Q = 330 * MiB, WS_KV = 354 * MiB;
constexpr size_t WS_OA = 386 * MiB;
constexpr size_t WS_PB = 434 * MiB;
constexpr size_t WS_END = 482 * MiB;
constexpr size_t WS_U = 108 * MiB;
constexpr size_t WS_Y = 236 * MiB;
namespace pg8 {
#define PG8_LAS __attribute__((address_space(3)))
typedef unsigned short bf16_t;
typedef short bf16x8 __attribute__((ext_vector_type(8)));
typedef float f32x4 __attribute__((ext_vector_type(4)));
typedef unsigned u32x4 __attribute__((ext_vector_type(4)));
constexpr int BM = 256, BK = 64, HALF = 128, HTB = HALF * BK * 2  , STAGE_BYTES = 8 * HTB, NXCD = 8, WGM = 8;

__host__ __device__ __forceinline__ int lds_byte(int r, int c) { const int st = (r >> 4) * 2 + (c >> 5), rr = r & 15, cc = c & 31, ob = rr * 64 + cc * 2; return st * 1024 + (ob ^ (((ob >> 9) & 1) << 5)); }
__host__ __device__ __forceinline__ void stage_rc(int b, int& R, int& C) { const int st = b / 1024, sb = b % 1024, swz = sb ^ (((sb >> 9) & 1) << 5); R = (st >> 1) * 16 + swz / 64; C = (st & 1) * 32 + (swz % 64) / 2; }
__host__ __device__ __forceinline__ int perm32(int rho) { const int n = rho >> 4, i = rho & 15; return 8 * (i >> 2) + 4 * n + (i & 3); }

struct Unit { int pm, pn; };
struct Gemm { const bf16_t* A; const bf16_t* Bt; int M, N, K, lda, ldb; };

struct StaticOrder {
    int nM, nN, nwg, G, c;
    __host__ __device__ void init(int M, int N, int G_, int c_) { nM = M / BM; nN = N / BM; nwg = nM * nN; G = G_; c = c_; }
    __host__ __device__ bool next(int i, Unit& u) const {
        const long L = (long)i * G + c; if (L >= nwg) return false;
        int wgid = (int)L; { const int q = nwg / NXCD, r = nwg % NXCD, xcd = wgid % NXCD, off = wgid / NXCD; wgid = (xcd < r ? xcd * (q + 1) : r * (q + 1) + (xcd - r) * q) + off; }
        const int nig = WGM * nN, gid = wgid / nig, fm = gid * WGM, gsz = (nM - fm) < WGM ? (nM - fm) : WGM;
        u.pm = fm + ((wgid % nig) % gsz); u.pn = (wgid % nig) / gsz; return true;
    }
    __device__ __forceinline__ void a_ready(const Unit&) const {}
    __device__ __forceinline__ void done(const Unit&) const {}
};


template <class Epi, class Sched, bool ALIGN_EPI = false, bool SP2 = false>
__device__ __forceinline__ void gemm_phase(PG8_LAS unsigned char* lds, const Gemm g, const Sched& S, const Epi& E) {
    int tid = threadIdx.x; asm volatile("" : "+v"(tid));
    const int wid = __builtin_amdgcn_readfirstlane(tid >> 6), lane = tid & 63, wr = wid >> 2, wc = wid & 3, fr = lane & 15, fq = lane >> 4;
    int K = g.K; asm volatile("" : "+s"(K)); const int nt = K / BK;
    unsigned voffA[2], voffB[2];
#pragma unroll
    for (int i = 0; i < 2; ++i) { int R, C; stage_rc(tid * 16 + i * 8192, R, C); const int Rb = Epi::PERM ? ((R & ~31) + perm32(R & 31)) : R;
        voffA[i] = (unsigned)(R * g.lda + C) * 2u; voffB[i] = (unsigned)(Rb * g.ldb + C) * 2u; }
    const size_t kstep = (size_t)(BK * 2);
    const size_t hstepA = (size_t)HALF * g.lda * 2, hstepB = (size_t)HALF * g.ldb * 2;
    const size_t tstepA = 2 * hstepA, tstepB = 2 * hstepB;
    const unsigned ldsw = (unsigned)wid * 1024u;
    const int aoff = lds_byte(wr * 64 + fr, fq * 8), boff = lds_byte(wc * 32 + fr, fq * 8);
#define PG8_SA(b, h) (((b) * 2 + (h)) * HTB)
#define PG8_SB(b, h) ((4 + (b) * 2 + (h)) * HTB)
#define PG8_STAGE(bufoff, gbase, voff) do { _Pragma("unroll") for (int _i = 0; _i < 2; ++_i) \
        __builtin_amdgcn_global_load_lds((const unsigned*)((const char*)(gbase) + (voff)[_i]), (PG8_LAS unsigned*)(lds + (bufoff) + ldsw + _i * 8192), 16, 0, 0); } while (0)
#define PG8_LDA(dst, b, h) do { _Pragma("unroll") for (int m = 0; m < 4; ++m) _Pragma("unroll") for (int k = 0; k < 2; ++k) dst[m][k] = *(const PG8_LAS bf16x8*)(lds + PG8_SA(b, h) + aoff + m * 2048 + k * 1024); } while (0)
#define PG8_LDB(dst, b, h) do { _Pragma("unroll") for (int n = 0; n < 2; ++n) _Pragma("unroll") for (int k = 0; k < 2; ++k) dst[n][k] = *(const PG8_LAS bf16x8*)(lds + PG8_SB(b, h) + boff + n * 2048 + k * 1024); } while (0)
#define PG8_MMA(ai, bj, At, Bt) do { __builtin_amdgcn_s_setprio(1); _Pragma("unroll") for (int m = 0; m < 4; ++m) _Pragma("unroll") for (int n = 0; n < 2; ++n) _Pragma("unroll") for (int k = 0; k < 2; ++k) \
        acc[ai][bj][m][n] = __builtin_amdgcn_mfma_f32_16x16x32_bf16(Bt[n][k], At[m][k], acc[ai][bj][m][n], 0, 0, 0); __builtin_amdgcn_s_setprio(0); } while (0)
#define PG8_WAIT_V(n) asm volatile("s_waitcnt vmcnt(" #n ")" ::: "memory")
#define PG8_WAIT_L(n) asm volatile("s_waitcnt lgkmcnt(" #n ")" ::: "memory")
#define PG8_BAR __builtin_amdgcn_s_barrier()
#define PG8_SCHED __builtin_amdgcn_sched_barrier(0)
    Unit cur, nxt; int ui = 0;
    if (!S.next(0, cur)) return;
    f32x4 acc[2][2][4][2];
#pragma unroll
    for (int a = 0; a < 2; ++a)
#pragma unroll
        for (int b = 0; b < 2; ++b)
#pragma unroll
            for (int m = 0; m < 4; ++m)
#pragma unroll
                for (int n = 0; n < 2; ++n) acc[a][b][m][n] = (f32x4){0.f, 0.f, 0.f, 0.f};
    bf16x8 At[4][2], B0[2][2], B1[2][2];
    const char* cA = (const char*)g.A + (size_t)cur.pm * tstepA; const char* cB = (const char*)g.Bt + (size_t)cur.pn * tstepB;
    S.a_ready(cur);
    if constexpr (SP2) {
        PG8_STAGE(PG8_SB(0, 0), cB, voffB); PG8_STAGE(PG8_SB(0, 1), cB + hstepB, voffB); PG8_STAGE(PG8_SA(0, 0), cA, voffA); PG8_STAGE(PG8_SA(0, 1), cA + hstepA, voffA);
        if (wr == 1) PG8_BAR;
        PG8_WAIT_V(2); PG8_BAR;
        PG8_STAGE(PG8_SB(1, 0), cB + kstep, voffB); PG8_STAGE(PG8_SA(1, 0), cA + kstep, voffA); PG8_STAGE(PG8_SB(1, 1), cB + hstepB + kstep, voffB);
        PG8_WAIT_V(6); PG8_BAR;
    } else {
        PG8_STAGE(PG8_SB(0, 0), cB, voffB); PG8_STAGE(PG8_SA(0, 0), cA, voffA); PG8_STAGE(PG8_SB(0, 1), cB + hstepB, voffB); PG8_STAGE(PG8_SA(0, 1), cA + hstepA, voffA);
        if (wr == 1) PG8_BAR;
        PG8_WAIT_V(4); PG8_BAR;
        PG8_STAGE(PG8_SB(1, 0), cB + kstep, voffB); PG8_STAGE(PG8_SA(1, 0), cA + kstep, voffA); PG8_STAGE(PG8_SB(1, 1), cB + hstepB + kstep, voffB);
        PG8_WAIT_V(6); PG8_BAR;
    }
    for (;;) {
        const bool has_next = S.next(ui + 1, nxt);
        const char* nA = has_next ? (const char*)g.A + (size_t)nxt.pm * tstepA : cA; const char* nB = has_next ? (const char*)g.Bt + (size_t)nxt.pn * tstepB : cB;
        for (int t = 0; t < nt; t += 2) {
            const bool last = (t == nt - 2);
            const char* a1 = cA + (size_t)(t + 1) * kstep;
            const char* a2 = last ? nA : cA + (size_t)(t + 2) * kstep; const char* b2 = last ? nB : cB + (size_t)(t + 2) * kstep;
            const char* a3 = a2 + kstep; const char* b3 = b2 + kstep;
            if (last && has_next) S.a_ready(nxt);
            if constexpr (SP2) {
            PG8_LDB(B0, 0, 0); PG8_LDB(B1, 0, 1); PG8_SCHED; PG8_LDA(At, 0, 0); PG8_STAGE(PG8_SA(1, 1), a1 + hstepA, voffA);
            PG8_WAIT_V(8); PG8_WAIT_L(0); PG8_BAR; PG8_MMA(0, 0, At, B0); PG8_MMA(0, 1, At, B1); PG8_BAR; PG8_SCHED;
            PG8_LDA(At, 0, 1); PG8_STAGE(PG8_SB(0, 0), b2, voffB); PG8_STAGE(PG8_SB(0, 1), b2 + hstepB, voffB); PG8_STAGE(PG8_SA(0, 0), a2, voffA);
            PG8_WAIT_V(8); PG8_WAIT_L(0); PG8_BAR; PG8_MMA(1, 0, At, B0); PG8_MMA(1, 1, At, B1); PG8_BAR; PG8_SCHED;
            PG8_LDB(B0, 1, 0); PG8_LDB(B1, 1, 1); PG8_SCHED; PG8_LDA(At, 1, 0); PG8_STAGE(PG8_SA(0, 1), a2 + hstepA, voffA);
            PG8_WAIT_V(8); PG8_WAIT_L(0); PG8_BAR; PG8_MMA(0, 0, At, B0); PG8_MMA(0, 1, At, B1); PG8_BAR; PG8_SCHED;
            PG8_LDA(At, 1, 1); PG8_STAGE(PG8_SB(1, 0), b3, voffB); PG8_STAGE(PG8_SB(1, 1), b3 + hstepB, voffB); PG8_STAGE(PG8_SA(1, 0), a3, voffA);
            PG8_WAIT_V(8); PG8_WAIT_L(0); PG8_BAR; PG8_MMA(1, 0, At, B0); PG8_MMA(1, 1, At, B1); PG8_BAR; PG8_SCHED;
            } else {
            PG8_LDB(B0, 0, 0); PG8_SCHED; PG8_LDA(At, 0, 0); PG8_STAGE(PG8_SA(1, 1), a1 + hstepA, voffA);
            PG8_WAIT_L(8); PG8_BAR; PG8_WAIT_L(0); PG8_MMA(0, 0, At, B0); PG8_BAR; PG8_SCHED;
            PG8_LDB(B1, 0, 1); PG8_STAGE(PG8_SB(0, 0), b2, voffB);
            PG8_BAR; PG8_WAIT_L(0); PG8_MMA(0, 1, At, B1); PG8_BAR;
            PG8_LDA(At, 0, 1); PG8_STAGE(PG8_SA(0, 0), a2, voffA);
            PG8_BAR; PG8_WAIT_L(0); PG8_MMA(1, 0, At, B0); PG8_BAR; PG8_SCHED;
            PG8_STAGE(PG8_SB(0, 1), b2 + hstepB, voffB);
            PG8_WAIT_V(6); PG8_BAR; PG8_MMA(1, 1, At, B1); PG8_BAR;
            PG8_LDB(B0, 1, 0); PG8_SCHED; PG8_LDA(At, 1, 0); PG8_STAGE(PG8_SA(0, 1), a2 + hstepA, voffA);
            PG8_WAIT_L(8); PG8_BAR; PG8_WAIT_L(0); PG8_MMA(0, 0, At, B0); PG8_BAR; PG8_SCHED;
            PG8_LDB(B1, 1, 1); PG8_STAGE(PG8_SB(1, 0), b3, voffB);
            PG8_BAR; PG8_WAIT_L(0); PG8_MMA(0, 1, At, B1); PG8_BAR;
            PG8_LDA(At, 1, 1); PG8_STAGE(PG8_SA(1, 0), a3, voffA);
            PG8_BAR; PG8_WAIT_L(0); PG8_MMA(1, 0, At, B0); PG8_BAR; PG8_SCHED;
            PG8_STAGE(PG8_SB(1, 1), b3 + hstepB, voffB);
            PG8_WAIT_V(6); PG8_BAR; PG8_MMA(1, 1, At, B1); PG8_BAR;
            }
        }
        if constexpr (ALIGN_EPI) { if (wr == 0) PG8_BAR; }
        if constexpr (!Epi::AFTER_DRAIN) { E(acc, cur, wr, wc, fr, fq); S.done(cur); }
        if (!has_next) break;
#pragma unroll
        for (int a = 0; a < 2; ++a)
#pragma unroll
            for (int b = 0; b < 2; ++b)
#pragma unroll
                for (int m = 0; m < 4; ++m)
#pragma unroll
                    for (int n = 0; n < 2; ++n) acc[a][b][m][n] = (f32x4){0.f, 0.f, 0.f, 0.f};
        cur = nxt; cA = nA; cB = nB; ++ui;
        if constexpr (ALIGN_EPI) { if (wr == 1) PG8_BAR; }
    }
    PG8_WAIT_V(0);
    if constexpr (!ALIGN_EPI) { if (wr == 0) PG8_BAR; }
    PG8_BAR;
    if constexpr (Epi::AFTER_DRAIN) { E.fused(acc, cur, wr, wc, fr, fq, lds, wid, lane); S.done(cur); }
#undef PG8_SA
#undef PG8_SB
#undef PG8_STAGE
#undef PG8_LDA
#undef PG8_LDB
#undef PG8_MMA
#undef PG8_WAIT_V
#undef PG8_WAIT_L
#undef PG8_BAR
#undef PG8_SCHED
}
}

using pg8::bf16_t; using pg8::f32x4; using pg8::u32x4; using pg8::bf16x8;
constexpr float QSCALE_MLA = 0.10206207261596575f * LOG2E;
constexpr float QSCALE_64 = 0.125f * LOG2E;
__device__ __forceinline__ float sigmoidf_fast(float v) { return __builtin_amdgcn_rcpf(1.f + __builtin_amdgcn_exp2f(-v * LOG2E)); }
__device__ __forceinline__ u32x4 pack8(const f32x4 a, const f32x4 b) { u32x4 w; w.x = pk2(a[0], a[1]); w.y = pk2(a[2], a[3]); w.z = pk2(b[0], b[1]); w.w = pk2(b[2], b[3]); return w; }
__device__ __forceinline__ void rope8(f32x4& a, f32x4& b, const f32x4 c, const f32x4 s) {
    f32x4 ra, rb;
    ra[0] = a[0] * c[0] - a[1] * s[0]; ra[1] = a[1] * c[0] + a[0] * s[0];
    ra[2] = a[2] * c[1] - a[3] * s[1]; ra[3] = a[3] * c[1] + a[2] * s[1];
    rb[0] = b[0] * c[2] - b[1] * s[2]; rb[1] = b[1] * c[2] + b[0] * s[2];
    rb[2] = b[2] * c[3] - b[3] * s[3]; rb[3] = b[3] * c[3] + b[2] * s[3];
    a = ra; b = rb;
}

struct EpiZ {
    static constexpr bool PERM = true, AFTER_DRAIN = false;
    unsigned char* ws; const float* rope; int tok0;
    __device__ __forceinline__ void operator()(const f32x4 (&acc)[2][2][4][2], const pg8::Unit& u, int wr, int wc, int fr, int fq) const {
        const int pn = u.pn, row0 = u.pm * 256 + wr * 64 + fr, cl = wc * 32 + 8 * fq;
        if (pn == 12) {
            bf16_t* CQ = (bf16_t*)(ws + WS_CQ); float* SSQ = (float*)(ws + WS_SSQ);
#pragma unroll
            for (int ai = 0; ai < 2; ++ai)
#pragma unroll
                for (int m = 0; m < 4; ++m) { const int r = row0 + ai * 128 + m * 16; float s = 0.f;
#pragma unroll
                    for (int bj = 0; bj < 2; ++bj) { const f32x4 v0 = acc[ai][bj][m][0], v1 = acc[ai][bj][m][1];
                        s += (v0[0] * v0[0] + v0[1] * v0[1]) + (v0[2] * v0[2] + v0[3] * v0[3]) + (v1[0] * v1[0] + v1[1] * v1[1]) + (v1[2] * v1[2] + v1[3] * v1[3]);
                        *(u32x4*)(CQ + (size_t)r * 256 + bj * 128 + cl) = pack8(v0, v1); }
                    s += __shfl_xor(s, 16); s += __shfl_xor(s, 32);
                    if (fq == 0) SSQ[r * 4 + wc] = s; }
        } else if (pn == 13) {
            bf16_t* CKV = (bf16_t*)(ws + WS_CKV); bf16_t* KR = (bf16_t*)(ws + WS_KR); float* SSKV = (float*)(ws + WS_SSKV);
#pragma unroll
            for (int ai = 0; ai < 2; ++ai)
#pragma unroll
                for (int m = 0; m < 4; ++m) { const int r = row0 + ai * 128 + m * 16;
                    const f32x4 v0 = acc[ai][0][m][0], v1 = acc[ai][0][m][1];
                    float s = (v0[0] * v0[0] + v0[1] * v0[1]) + (v0[2] * v0[2] + v0[3] * v0[3]) + (v1[0] * v1[0] + v1[1] * v1[1]) + (v1[2] * v1[2] + v1[3] * v1[3]);
                    *(u32x4*)(CKV + (size_t)r * 128 + cl) = pack8(v0, v1);
                    s += __shfl_xor(s, 16); s += __shfl_xor(s, 32);
                    if (fq == 0) SSKV[r * 4 + wc] = s;
                    if (wc == 0) { f32x4 a = acc[ai][1][m][0], b = acc[ai][1][m][1];
                        const float* rp = rope + (size_t)(tok0 + r) * 32 + 4 * fq;
                        rope8(a, b, *(const f32x4*)rp, *(const f32x4*)(rp + 16));
                        *(u32x4*)(KR + (size_t)r * 32 + 8 * fq) = pack8(a, b); }
                    asm volatile("" ::: "memory"); }
        } else {
            bf16_t* base; int ldc, col; float sc = 1.f; const bool sig = pn < 12;
            if (pn < 12) { base = (bf16_t*)(ws + WS_G); ldc = 3072; col = pn * 256; }
            else if (pn < 17) { base = (bf16_t*)(ws + WS_DQ); ldc = 768; col = (pn - 14) * 256; sc = QSCALE_64; }
            else if (pn < 20) { base = (bf16_t*)(ws + WS_DK); ldc = 768; col = (pn - 17) * 256; }
            else if (pn < 22) { base = (bf16_t*)(ws + WS_DV); ldc = 512; col = (pn - 20) * 256; }
            else if (pn < 24) { base = (bf16_t*)(ws + WS_FQ); ldc = 512; col = (pn - 22) * 256; sc = QSCALE_64; }
            else if (pn < 26) { base = (bf16_t*)(ws + WS_FK); ldc = 512; col = (pn - 24) * 256; }
            else { base = (bf16_t*)(ws + WS_FV); ldc = 512; col = (pn - 26) * 256; }
#pragma unroll
            for (int ai = 0; ai < 2; ++ai)
#pragma unroll
                for (int m = 0; m < 4; ++m) { bf16_t* rowp = base + (size_t)(row0 + ai * 128 + m * 16) * ldc + col + cl;
#pragma unroll
                    for (int bj = 0; bj < 2; ++bj) { f32x4 v0 = acc[ai][bj][m][0] * sc, v1 = acc[ai][bj][m][1] * sc;
                        if (sig) {
#pragma unroll
                            for (int e = 0; e < 4; ++e) { v0[e] = sigmoidf_fast(v0[e]); v1[e] = sigmoidf_fast(v1[e]); } }
                        *(u32x4*)(rowp + bj * 128) = pack8(v0, v1); } }
        }
    }
};

struct EpiUpQ {
    static constexpr bool PERM = true, AFTER_DRAIN = false;
    unsigned char* ws; const float* rope; int tok0;
    __device__ __forceinline__ void operator()(const f32x4 (&acc)[2][2][4][2], const pg8::Unit& u, int wr, int wc, int fr, int fq) const {
        bf16_t* Q = (bf16_t*)(ws + WS_Q); const float* SSQ = (const float*)(ws + WS_SSQ);
        const int row0 = u.pm * 256 + wr * 64 + fr, cl = wc * 32 + 8 * fq;
#pragma unroll
        for (int ai = 0; ai < 2; ++ai)
#pragma unroll
            for (int m = 0; m < 4; ++m) { const int r = row0 + ai * 128 + m * 16;
                const f32x4 ss = *(const f32x4*)(SSQ + r * 4);
                const float rs = QSCALE_MLA * __builtin_amdgcn_rsqf(((ss[0] + ss[1]) + (ss[2] + ss[3])) * (1.f / 256.f) + EPS);
#pragma unroll
                for (int bj = 0; bj < 2; ++bj) { f32x4 a = acc[ai][bj][m][0] * rs, b = acc[ai][bj][m][1] * rs;
                    const int slab = u.pn * 8 + bj * 4 + wc;
                    if (slab % 3 == 2) { const float* rp = rope + (size_t)(tok0 + r) * 32 + 4 * fq; rope8(a, b, *(const f32x4*)rp, *(const f32x4*)(rp + 16)); }
                    *(u32x4*)(Q + (size_t)r * 768 + u.pn * 256 + bj * 128 + cl) = pack8(a, b); }
                asm volatile("" ::: "memory"); }
    }
};
struct EpiUpKV {
    static constexpr bool PERM = true, AFTER_DRAIN = false;
    unsigned char* ws;
    __device__ __forceinline__ void operator()(const f32x4 (&acc)[2][2][4][2], const pg8::Unit& u, int wr, int wc, int fr, int fq) const {
        bf16_t* KV = (bf16_t*)(ws + WS_KV); const float* SS = (const float*)(ws + WS_SSKV);
        const int row0 = u.pm * 256 + wr * 64 + fr, cl = wc * 32 + 8 * fq;
#pragma unroll
        for (int ai = 0; ai < 2; ++ai)
#pragma unroll
            for (int m = 0; m < 4; ++m) { const int r = row0 + ai * 128 + m * 16;
                const f32x4 ss = *(const f32x4*)(SS + r * 4);
                const float rs = __builtin_amdgcn_rsqf(((ss[0] + ss[1]) + (ss[2] + ss[3])) * (1.f / 128.f) + EPS);
#pragma unroll
                for (int bj = 0; bj < 2; ++bj) *(u32x4*)(KV + (size_t)r * 1024 + u.pn * 256 + bj * 128 + cl) = pack8(acc[ai][bj][m][0] * rs, acc[ai][bj][m][1] * rs);
                asm volatile("" ::: "memory"); }
    }
};
struct EpiMerge {
    static constexpr bool PERM = true, AFTER_DRAIN = false;
    unsigned char* ws; bf16_t* MG;
    __device__ __forceinline__ void operator()(const f32x4 (&acc)[2][2][4][2], const pg8::Unit& u, int wr, int wc, int fr, int fq) const {
        const bf16_t* G = (const bf16_t*)(ws + WS_G); float* T = (float*)(ws + WS_Y);
        const int b = u.pm >> 6, pml = u.pm & 63, pnl = u.pn & 3;
        const int row0 = pml * 256 + wr * 64 + fr, col0 = pnl * 256 + wc * 32 + 8 * fq;
#pragma unroll
        for (int ai = 0; ai < 2; ++ai)
#pragma unroll
            for (int m = 0; m < 4; ++m) { const int r = row0 + ai * 128 + m * 16;
#pragma unroll
                for (int bj = 0; bj < 2; ++bj) { const int c = col0 + bj * 128;
                    const u32x4 gw = *(const u32x4*)(G + (size_t)r * 3072 + b * 1024 + c);
                    f32x4 g0 = {bflo(gw.x), bfhi(gw.x), bflo(gw.y), bfhi(gw.y)}, g1 = {bflo(gw.z), bfhi(gw.z), bflo(gw.w), bfhi(gw.w)};
                    f32x4 v0 = acc[ai][bj][m][0] * g0, v1 = acc[ai][bj][m][1] * g1;
                    float* tp = T + (size_t)r * 1024 + c;
                    if (b > 0) { v0 += *(const f32x4*)tp; v1 += *(const f32x4*)(tp + 4); }
                    if (b < 2) { *(f32x4*)tp = v0; *(f32x4*)(tp + 4) = v1; }
                    else *(u32x4*)(MG + (size_t)r * 1024 + c) = pack8(v0, v1); }
                asm volatile("" ::: "memory"); }
    }
};
struct EpiF32 {
    static constexpr bool PERM = false, AFTER_DRAIN = false;
    unsigned char* ws;
    __device__ __forceinline__ void operator()(const f32x4 (&acc)[2][2][4][2], const pg8::Unit& u, int wr, int wc, int fr, int fq) const {
        float* Y = (float*)(ws + WS_Y); float* SS = (float*)(ws + WS_SSY);
        const int row0 = u.pm * 256 + wr * 64 + fr, col0 = u.pn * 256 + wc * 32 + 4 * fq;
#pragma unroll
        for (int ai = 0; ai < 2; ++ai)
#pragma unroll
            for (int m = 0; m < 4; ++m) { const int r = row0 + ai * 128 + m * 16; float s = 0.f;
#pragma unroll
                for (int bj = 0; bj < 2; ++bj)
#pragma unroll
                    for (int n = 0; n < 2; ++n) { const f32x4 v = acc[ai][bj][m][n]; s += (v[0] * v[0] + v[1] * v[1]) + (v[2] * v[2] + v[3] * v[3]);
                        *(f32x4*)(Y + (size_t)r * 1024 + col0 + bj * 128 + n * 16) = v; }
                s += __shfl_xor(s, 16); s += __shfl_xor(s, 32);
                if (fq == 0) SS[r * 16 + u.pn * 4 + wc] = s; }
    }
};
struct EpiUp {
    static constexpr bool PERM = true, AFTER_DRAIN = false;
    unsigned char* ws;
    __device__ __forceinline__ void operator()(const f32x4 (&acc)[2][2][4][2], const pg8::Unit& u, int wr, int wc, int fr, int fq) const {
        bf16_t* U = (bf16_t*)(ws + WS_U);
        const int row0 = u.pm * 256 + wr * 64 + fr, col0 = u.pn * 256 + wc * 32 + 8 * fq;
#pragma unroll
        for (int ai = 0; ai < 2; ++ai)
#pragma unroll
            for (int m = 0; m < 4; ++m) { bf16_t* rowp = U + (size_t)(row0 + ai * 128 + m * 16) * FF + col0;
#pragma unroll
                for (int bj = 0; bj < 2; ++bj) { f32x4 v0 = acc[ai][bj][m][0], v1 = acc[ai][bj][m][1];
#pragma unroll
                    for (int e = 0; e < 4; ++e) { const float a = fmaxf(v0[e], 0.f), b = fmaxf(v1[e], 0.f); v0[e] = a * a; v1[e] = b * b; }
                    *(u32x4*)(rowp + bj * 128) = pack8(v0, v1); } }
    }
};
struct MergeOrder {
    int G, c;
    __device__ bool next(int i, pg8::Unit& u) const { const int tile = c + G * (i / 3), b = i % 3; if (tile >= 256) return false; u.pm = b * 64 + (tile >> 2); u.pn = b * 4 + (tile & 3); return true; }
    __device__ __forceinline__ void a_ready(const pg8::Unit&) const {}
    __device__ __forceinline__ void done(const pg8::Unit&) const {}
};

struct AUnit {
    const bf16_t* q; long qs; const bf16_t* k; long ks; const bf16_t* k2; long k2s; const bf16_t* v; long vs;
    bf16_t* o; long os; float* lse; long lses;
    const int* posq; const int* posk; const int* tmm;
    int t0, t1, tq0, dil, bcol;
};
__device__ __forceinline__ int t5_bucket(int rel) {
    const int n = rel < 0 ? -rel : rel;
    const int b = n < 8 ? n : n < 12 ? 8 : n < 16 ? 9 : n < 23 ? 10 : n < 32 ? 11 : n < 46 ? 12 : n < 64 ? 13 : n < 91 ? 14 : 15;
    return b + (rel > 0 ? 16 : 0);
}
__device__ __forceinline__ int crow(int r, int hi) { return (r & 3) + 8 * (r >> 2) + 4 * hi; }
__device__ __forceinline__ int clamp128(int v) { return (v < -128 ? -128 : (v > 128 ? 128 : v)) + 128; }
typedef short v4i16_t __attribute__((ext_vector_type(4)));
__device__ __forceinline__ s16x4 vtr(const LAS unsigned char* p) { return __builtin_bit_cast(s16x4, __builtin_amdgcn_ds_read_tr16_b64_v4i16((LAS v4i16_t*)p)); }
__device__ __forceinline__ float xhalf_max(float m) { auto rr = __builtin_amdgcn_permlane32_swap(__float_as_uint(m), __float_as_uint(m), false, false); return fmaxf(__uint_as_float(rr[0]), __uint_as_float(rr[1])); }
__device__ __forceinline__ float xhalf_sum(float m) { auto rr = __builtin_amdgcn_permlane32_swap(__float_as_uint(m), __float_as_uint(m), false, false); return __uint_as_float(rr[0]) + __uint_as_float(rr[1]); }

template <int MODE>
__device__ __forceinline__ void attn_unit(LAS unsigned char* lds, const AUnit& U, const float* __restrict__ rel_bias) {
    constexpr int DQK = MODE == 0 ? 96 : 64, DV = MODE == 0 ? 64 : 128;
    constexpr int KP = DQK * 2 + 16, VP = MODE == 0 ? 192 : 320;
    constexpr int KCPR = DQK / 8, VCPR = DV / 8, NKC = 64 * KCPR, NVC = 64 * VCPR, NS = DQK / 16, NB = DV / 32;
    constexpr int KBUF = 64 * 208, VBUF = 64 * 320, K_OFF = 0, V_OFF = 2 * KBUF, BT_OFF = V_OFF + 2 * VBUF;
    int tid = threadIdx.x; asm volatile("" : "+v"(tid));
    const int lane = tid & 63, wid = __builtin_amdgcn_readfirstlane(tid >> 6), q = lane & 31, hi = lane >> 5;
    LAS float* btab = (LAS float*)(lds + BT_OFF);
    if (MODE != 0) { for (int i = tid; i < 257; i += 512) btab[i] = LOG2E * rel_bias[t5_bucket(i - 128) * 20 + U.bcol]; }
    const bf16_t* src[3]; int dst[3];
    { const int row = tid >> 3, cc = tid & 7;
      src[0] = U.k + (long)row * U.ks + cc * 8 + (long)U.t0 * 64 * U.ks; dst[0] = K_OFF + row * KP + cc * 16;
      if (MODE == 0) {
          src[1] = U.v + (long)row * U.vs + cc * 8 + (long)U.t0 * 64 * U.vs; dst[1] = V_OFF + row * VP + cc * 16;
          const int r2 = (tid & 255) >> 2, c2 = tid & 3;
          src[2] = U.k2 + (long)r2 * U.k2s + c2 * 8 + (long)U.t0 * 64 * U.k2s; dst[2] = K_OFF + r2 * KP + 128 + c2 * 16;
      } else {
#pragma unroll
          for (int s = 1; s < 3; ++s) { const int c2 = tid + 512 * (s - 1), r2 = c2 >> 4, c3 = c2 & 15;
              src[s] = U.v + (long)r2 * U.vs + c3 * 8 + (long)U.t0 * 64 * U.vs; dst[s] = V_OFF + r2 * VP + c3 * 16; }
      } }
    const long step0 = 64 * U.ks, step1 = MODE == 0 ? 64 * U.vs : 64 * U.vs, step2 = MODE == 0 ? 64 * U.k2s : 64 * U.vs;
    const bool s2ok = MODE != 0 || tid < 256;
    const bf16_t* qrow = U.q + (long)(wid * 32 + q) * U.qs;
    bf16x8 qf[NS];
#pragma unroll
    for (int s = 0; s < NS; ++s) qf[s] = *(const bf16x8*)(qrow + 16 * s + 8 * hi);
    int pq = 0, qmin = 0, qmax = 0;
    if (MODE == 1) { pq = U.posq[wid * 32 + q]; qmin = pq; qmax = pq;
#pragma unroll
        for (int o = 1; o < 32; o <<= 1) { qmin = min(qmin, __shfl_xor(qmin, o)); qmax = max(qmax, __shfl_xor(qmax, o)); } }
    const int tq = U.tq0 + wid * 32 + q;
    const int wt0 = (U.tq0 >> 6) + (wid >> 1) - 1, wt1 = wt0 + 2;
    float m_run = -1e30f, l_run = 0.f;
    f32x16 O[NB];
#pragma unroll
    for (int b = 0; b < NB; ++b)
#pragma unroll
        for (int r = 0; r < 16; ++r) O[b][r] = 0.f;
    u32x4 st[3];
    st[0] = *(const u32x4*)src[0]; st[1] = *(const u32x4*)src[1]; st[2] = *(const u32x4*)src[2]; src[0] += step0; src[1] += step1; src[2] += step2;
    *(LAS u32x4*)(lds + dst[0]) = st[0]; *(LAS u32x4*)(lds + dst[1]) = st[1]; if (s2ok) *(LAS u32x4*)(lds + dst[2]) = st[2];
    __syncthreads();
    for (int t = U.t0; t < U.t1; ++t) {
        const int buf = (t - U.t0) & 1;
        const bool more = t + 1 < U.t1;
        if (more) { st[0] = *(const u32x4*)src[0]; st[1] = *(const u32x4*)src[1]; st[2] = *(const u32x4*)src[2]; src[0] += step0; src[1] += step1; src[2] += step2; }
        if (MODE != 2 || (t >= wt0 && t <= wt1)) {
            const LAS unsigned char* kb = lds + K_OFF + buf * KBUF + q * KP + hi * 16;
            f32x16 p0, p1;
#pragma unroll
            for (int r = 0; r < 16; ++r) { p0[r] = 0.f; p1[r] = 0.f; }
#pragma unroll
            for (int s = 0; s < NS; ++s) {
                const bf16x8 a0 = *(const LAS bf16x8*)(kb + s * 32), a1 = *(const LAS bf16x8*)(kb + 32 * KP + s * 32);
                p0 = __builtin_amdgcn_mfma_f32_32x32x16_bf16(a0, qf[s], p0, 0, 0, 0);
                p1 = __builtin_amdgcn_mfma_f32_32x32x16_bf16(a1, qf[s], p1, 0, 0, 0);
            }
            if (MODE == 1) {
                const int kmin = __builtin_amdgcn_readfirstlane(U.tmm[2 * t]), kmax = __builtin_amdgcn_readfirstlane(U.tmm[2 * t + 1]);
                if (kmin - qmax >= 128) { const float c = btab[256];
#pragma unroll
                    for (int r = 0; r < 16; ++r) { p0[r] += c; p1[r] += c; } }
                else if (kmax - qmin <= -128) { const float c = btab[0];
#pragma unroll
                    for (int r = 0; r < 16; ++r) { p0[r] += c; p1[r] += c; } }
                else { const int pk = U.posk[64 * t + lane];
#pragma unroll
                    for (int r = 0; r < 16; ++r) { const int kv = crow(r, hi); const int a = __shfl(pk, kv), b = __shfl(pk, kv + 32);
                        p0[r] += btab[clamp128(a - pq)]; p1[r] += btab[clamp128(b - pq)]; } }
            }
            if (MODE == 2) {
#pragma unroll
                for (int r = 0; r < 16; ++r) { const int rel0 = 64 * t + crow(r, hi) - tq, rel1 = rel0 + 32;
                    p0[r] = (rel0 >= -64 && rel0 <= 64) ? p0[r] + btab[clamp128(rel0 * U.dil)] : -INFINITY;
                    p1[r] = (rel1 >= -64 && rel1 <= 64) ? p1[r] + btab[clamp128(rel1 * U.dil)] : -INFINITY; }
            }
            float mx = fmaxf(p0[0], p1[0]);
#pragma unroll
            for (int r = 1; r < 16; ++r) mx = fmaxf(mx, fmaxf(p0[r], p1[r]));
            mx = xhalf_max(mx);
            const float m_new = fmaxf(m_run, mx), alpha = __builtin_amdgcn_exp2f(m_run - m_new);
            m_run = m_new;
            float ls = 0.f;
#pragma unroll
            for (int r = 0; r < 16; ++r) { p0[r] = __builtin_amdgcn_exp2f(p0[r] - m_new); p1[r] = __builtin_amdgcn_exp2f(p1[r] - m_new); ls += p0[r] + p1[r]; }
            l_run = l_run * alpha + ls;
#pragma unroll
            for (int b = 0; b < NB; ++b)
#pragma unroll
                for (int r = 0; r < 16; ++r) O[b][r] *= alpha;
            bf16x8 pw[4];
            { u32x4 w;
              w.x = pk2(p0[0], p0[1]); w.y = pk2(p0[2], p0[3]); w.z = pk2(p0[4], p0[5]); w.w = pk2(p0[6], p0[7]); pw[0] = __builtin_bit_cast(bf16x8, w);
              w.x = pk2(p0[8], p0[9]); w.y = pk2(p0[10], p0[11]); w.z = pk2(p0[12], p0[13]); w.w = pk2(p0[14], p0[15]); pw[1] = __builtin_bit_cast(bf16x8, w);
              w.x = pk2(p1[0], p1[1]); w.y = pk2(p1[2], p1[3]); w.z = pk2(p1[4], p1[5]); w.w = pk2(p1[6], p1[7]); pw[2] = __builtin_bit_cast(bf16x8, w);
              w.x = pk2(p1[8], p1[9]); w.y = pk2(p1[10], p1[11]); w.z = pk2(p1[12], p1[13]); w.w = pk2(p1[14], p1[15]); pw[3] = __builtin_bit_cast(bf16x8, w); }
            const LAS unsigned char* vb = lds + V_OFF + buf * VBUF + (4 * hi + ((lane & 15) >> 2)) * VP + ((lane >> 4) & 1) * 32 + (lane & 3) * 8;
#pragma unroll
            for (int b = 0; b < NB; ++b)
#pragma unroll
                for (int ks = 0; ks < 4; ++ks) {
                    const s16x4 lo = vtr(vb + ks * 16 * VP + b * 64), hh = vtr(vb + (ks * 16 + 8) * VP + b * 64);
                    const bf16x8 vf = {lo[0], lo[1], lo[2], lo[3], hh[0], hh[1], hh[2], hh[3]};
                    O[b] = __builtin_amdgcn_mfma_f32_32x32x16_bf16(vf, pw[ks], O[b], 0, 0, 0);
                }
        }
        if (more) { const int kb1 = (buf ^ 1) * KBUF, vb1 = (buf ^ 1) * VBUF;
            *(LAS u32x4*)(lds + dst[0] + kb1) = st[0]; *(LAS u32x4*)(lds + dst[1] + vb1) = st[1];
            if (s2ok) *(LAS u32x4*)(lds + dst[2] + (MODE == 0 ? kb1 : vb1)) = st[2]; }
        __syncthreads();
    }
    const float l_tot = xhalf_sum(l_run), inv = 1.f / l_tot;
    bf16_t* orow = U.o + (long)(wid * 32 + q) * U.os;
#pragma unroll
    for (int b = 0; b < NB; ++b)
#pragma unroll
        for (int g4 = 0; g4 < 4; ++g4) { u32x2 w; w.x = pk2(O[b][4 * g4] * inv, O[b][4 * g4 + 1] * inv); w.y = pk2(O[b][4 * g4 + 2] * inv, O[b][4 * g4 + 3] * inv);
            *(u32x2*)(orow + 32 * b + 8 * g4 + 4 * hi) = w; }
    if (MODE == 2) { if (hi == 0) U.lse[(long)(wid * 32 + q) * U.lses] = m_run + log2f(l_tot); }
}

struct Params { const float* in[21]; float* out; unsigned char* ws; double inv[16]; float lam_init[4]; int ph_lo, ph_hi; };
enum { I_X = 0, I_POS, I_RELB, I_GMIXPRE, I_WIN, I_GQ, I_WUQ, I_GKV, I_WUKV, I_LQ1, I_LK1, I_LQ2, I_LK2, I_GDIFF, I_WBR, I_WOUT, I_GMIXPOST, I_GMLPPRE, I_WUP, I_WDN, I_GMLPPOST };
constexpr int LDS_BYTES = 147456;

__device__ __forceinline__ void transpose_item(const float* __restrict__ W, int ldw, int srccol0, bool inter, const float* __restrict__ kscale, bf16_t* WT, int K, int drow0, int k0, LAS float* scr, int lane) {
    const int c = lane & 31, sc = inter ? ((c & 1) * 16 + (c >> 1)) : c;
#pragma unroll 8
    for (int i = 0; i < 32; ++i) { const int kk = 2 * i + (lane >> 5); float v = 0.f;
        if (srccol0 >= 0) { v = W[(size_t)(k0 + kk) * ldw + srccol0 + sc]; if (kscale) v *= kscale[k0 + kk]; }
        scr[kk * 33 + c] = v; }
    asm volatile("s_waitcnt lgkmcnt(0)" ::: "memory");
    const int ch = lane & 7;
#pragma unroll
    for (int j = 0; j < 4; ++j) { const int n = (lane >> 3) + 8 * j; const LAS float* s = scr + (8 * ch) * 33 + n;
        u32x4 o; o.x = pk2(s[0 * 33], s[1 * 33]); o.y = pk2(s[2 * 33], s[3 * 33]); o.z = pk2(s[4 * 33], s[5 * 33]); o.w = pk2(s[6 * 33], s[7 * 33]);
        *(u32x4*)(WT + (size_t)(drow0 + n) * K + k0 + 8 * ch) = o; }
    asm volatile("s_waitcnt lgkmcnt(0)" ::: "memory");
}
__device__ __forceinline__ void convert_layer(const Params& p, int l, LAS unsigned char* lds, int gw, int NGW, int wave, int lane) {
    LAS float* scr = (LAS float*)(lds + wave * 16384);
    unsigned char* ws = p.ws;
    constexpr int I_IN = 16 * 224, I_UQ = 4 * 24, I_UKV = 2 * 32, I_BR = 3 * 8 * 32, I_OUT = 16 * 32, I_UP = 16 * 128, I_DN = 64 * 32;
    constexpr int NIT = I_IN + I_UQ + I_UKV + I_BR + I_OUT + I_UP + I_DN;
    for (int it = gw; it < NIT; it += NGW) {
        int r = it;
        if (r < I_IN) { const int kb = r / 224, nb = r % 224, n = nb * 32; int sc; bool inter = false;
            if (n < 3072) sc = 4000 + n; else if (n < 3328) sc = n - 3072; else if (n < 3456) sc = 256 + (n - 3328); else if (n < 3488) { sc = 384; inter = true; } else if (n < 3584) sc = -1; else sc = n - 3168;
            transpose_item(p.in[I_WIN] + (size_t)l * DM * INC, INC, sc, inter, nullptr, (bf16_t*)(ws + WS_WIN), DM, n, kb * 64, scr, lane); continue; }
        r -= I_IN;
        if (r < I_UQ) { const int kb = r / 24, nb = r % 24;
            transpose_item(p.in[I_WUQ] + (size_t)l * 256 * 768, 768, nb * 32, (nb % 3) == 2, p.in[I_GQ] + l * 256, (bf16_t*)(ws + WS_WUQ), 256, nb * 32, kb * 64, scr, lane); continue; }
        r -= I_UQ;
        if (r < I_UKV) { const int kb = r / 32, nb = r % 32;
            transpose_item(p.in[I_WUKV] + (size_t)l * 128 * 1024, 1024, nb * 32, false, p.in[I_GKV] + l * 128, (bf16_t*)(ws + WS_WUKV), 128, nb * 32, kb * 64, scr, lane); continue; }
        r -= I_UKV;
        if (r < I_BR) { const int b = r / 256, r2 = r % 256, kb = r2 / 32, nb = r2 % 32;
            transpose_item(p.in[I_WBR] + ((size_t)l * 3 + b) * 512 * 1024, 1024, nb * 32, false, nullptr, (bf16_t*)(ws + WS_WBR), 512, b * 1024 + nb * 32, kb * 64, scr, lane); continue; }
        r -= I_BR;
        if (r < I_OUT) { const int kb = r / 32, nb = r % 32;
            transpose_item(p.in[I_WOUT] + (size_t)l * DM * DM, DM, nb * 32, false, nullptr, (bf16_t*)(ws + WS_WOUT), DM, nb * 32, kb * 64, scr, lane); continue; }
        r -= I_OUT;
        if (r < I_UP) { const int kb = r / 128, nb = r % 128;
            transpose_item(p.in[I_WUP] + (size_t)l * DM * FF, FF, nb * 32, false, nullptr, (bf16_t*)(ws + WS_WUP), DM, nb * 32, kb * 64, scr, lane); continue; }
        r -= I_UP;
        { const int kb = r / 32, nb = r % 32;
            transpose_item(p.in[I_WDN] + (size_t)l * FF * DM, DM, nb * 32, false, nullptr, (bf16_t*)(ws + WS_WDN), FF, nb * 32, kb * 64, scr, lane); }
    }
}
__device__ __forceinline__ void norm_row(const float* xsrc, float* xdst, const float* y, const float* ssy, const float* gpost, const float* gpre, bf16_t* xn, int lane) {
    f32x4 v[4];
#pragma unroll
    for (int j = 0; j < 4; ++j) v[j] = *(const f32x4*)(xsrc + 4 * lane + 256 * j);
    if (y) {
        float s = 0.f;
#pragma unroll
        for (int k = 0; k < 16; ++k) s += ssy[k];
        const float rs = 1.f / sqrtf(s * (1.f / 1024.f) + EPS);
#pragma unroll
        for (int j = 0; j < 4; ++j) { const f32x4 yy = *(const f32x4*)(y + 4 * lane + 256 * j), g = *(const f32x4*)(gpost + 4 * lane + 256 * j);
            v[j] += yy * rs * g; *(f32x4*)(xdst + 4 * lane + 256 * j) = v[j]; }
    }
    if (xn) {
        float s2 = 0.f;
#pragma unroll
        for (int j = 0; j < 4; ++j) s2 += (v[j][0] * v[j][0] + v[j][1] * v[j][1]) + (v[j][2] * v[j][2] + v[j][3] * v[j][3]);
        const float rs = 1.f / sqrtf(wave_sum(s2) * (1.f / 1024.f) + EPS);
#pragma unroll
        for (int j = 0; j < 4; ++j) { const f32x4 g = *(const f32x4*)(gpre + 4 * lane + 256 * j); const f32x4 o = v[j] * rs * g;
            u32x2 w; w.x = pk2(o[0], o[1]); w.y = pk2(o[2], o[3]); *(u32x2*)(xn + 4 * lane + 256 * j) = w; }
    }
}

__global__ void __launch_bounds__(512, 2) fwd_megakernel(Params p) {
    extern __shared__ __attribute__((aligned(16))) unsigned char lds_raw[];
    LAS unsigned char* lds = (LAS unsigned char*)lds_raw;
    cg::grid_group grid = cg::this_grid();
    for (int ph = p.ph_lo; ph < p.ph_hi; ++ph) {
    int tid = threadIdx.x; asm volatile("" : "+v"(tid) :: "memory");
    const int lane = tid & 63, wave = __builtin_amdgcn_readfirstlane(tid >> 6);
    const int G = gridDim.x, gw = blockIdx.x * 8 + wave, NGW = G * 8;
    unsigned char* ws = p.ws;
    const int* pos = (const int*)p.in[I_POS];

    if (ph == 0) {
        convert_layer(p, 0, lds, gw, NGW, wave, lane);
        float* rope = (float*)(ws + WS_ROPE);
        for (int i = blockIdx.x * 512 + tid; i < MALL * 16; i += G * 512) { const int tok = i >> 4, f = i & 15;
            const double rev = (double)pos[tok] * p.inv[f] * 0.15915494309189535; const float fr = (float)(rev - floor(rev));
            rope[tok * 32 + f] = __builtin_amdgcn_cosf(fr); rope[tok * 32 + 16 + f] = __builtin_amdgcn_sinf(fr); }
        int* tmm = (int*)(ws + WS_TMM);
        for (int i = gw; i < BATCH * 64; i += NGW) { int v = pos[i * 64 + lane], mn = v, mx = v;
#pragma unroll
            for (int o = 1; o < 64; o <<= 1) { mn = min(mn, __shfl_xor(mn, o)); mx = max(mx, __shfl_xor(mx, o)); }
            if (lane == 0) { tmm[2 * i] = mn; tmm[2 * i + 1] = mx; } }
        for (int r = gw; r < MALL; r += NGW)
            norm_row(p.in[I_X] + (size_t)r * DM, nullptr, nullptr, nullptr, nullptr, p.in[I_GMIXPRE], (bf16_t*)(ws + WS_XN) + (size_t)r * DM, lane);
    } else {
            const int pq_ = ph - 1, l = pq_ / 20, c = (pq_ / 10) & 1, kind = pq_ % 10;
            bf16_t* XN = (bf16_t*)(ws + WS_XN) + (size_t)c * MC * DM;
            const int tok0 = c * MC;
            const float* rope = (const float*)(ws + WS_ROPE);
            if (kind == 0) {
                pg8::Gemm g{XN, (const bf16_t*)(ws + WS_WIN), MC, NZ, DM, DM, DM}; pg8::StaticOrder S; S.init(MC, NZ, G, (int)blockIdx.x);
                EpiZ E{ws, rope, tok0};
                pg8::gemm_phase<EpiZ, pg8::StaticOrder, true, true>(lds, g, S, E);
            }
            else if (kind == 1) {
                { pg8::Gemm g{(const bf16_t*)(ws + WS_CQ), (const bf16_t*)(ws + WS_WUQ), MC, 768, 256, 256, 256}; pg8::StaticOrder S; S.init(MC, 768, G, (int)blockIdx.x);
                  EpiUpQ E{ws, rope, tok0}; pg8::gemm_phase<EpiUpQ, pg8::StaticOrder, true, true>(lds, g, S, E); }
                { pg8::Gemm g{(const bf16_t*)(ws + WS_CKV), (const bf16_t*)(ws + WS_WUKV), MC, 1024, 128, 128, 128}; pg8::StaticOrder S; S.init(MC, 1024, G, (int)blockIdx.x);
                  EpiUpKV E{ws}; pg8::gemm_phase<EpiUpKV, pg8::StaticOrder, true, true>(lds, g, S, E); }
            }
            else if (kind == 2) {
                const float* relb = p.in[I_RELB];
                for (int u = blockIdx.x; u < 1792; u += G) {
                    AUnit U{};
                    if (u < 512) {
                        const int qb = u & 15, h = (u >> 4) & 3, m = (u >> 6) & 1, b = u >> 7; const long row0 = (long)b * SEQ;
                        U.q = (const bf16_t*)(ws + WS_FQ) + (row0 + 256 * qb) * 512 + (m * 4 + h) * 64; U.qs = 512;
                        U.k = (const bf16_t*)(ws + WS_FK) + row0 * 512 + (m * 4 + h) * 64; U.ks = 512; U.k2 = U.k; U.k2s = 0;
                        U.v = (const bf16_t*)(ws + WS_FV) + row0 * 512 + h * 128; U.vs = 512;
                        U.o = XN + ((long)m * MC + row0 + 256 * qb) * 512 + h * 128; U.os = 512;
                        U.posq = pos + tok0 + row0 + 256 * qb; U.posk = pos + tok0 + row0; U.tmm = (const int*)(ws + WS_TMM) + (c * CB + b) * 128;
                        U.t0 = 0; U.t1 = 64; U.bcol = 12 + m * 4 + h;
                        attn_unit<1>(lds, U, relb);
                    } else if (u < 1024) {
                        const int v = u - 512, qb = v & 15, h = (v >> 4) & 7, b = v >> 7; const long row0 = (long)b * SEQ;
                        U.q = (const bf16_t*)(ws + WS_Q) + (row0 + 256 * qb) * 768 + h * 96; U.qs = 768;
                        U.k = (const bf16_t*)(ws + WS_KV) + row0 * 1024 + h * 128; U.ks = 1024;
                        U.k2 = (const bf16_t*)(ws + WS_KR) + row0 * 32; U.k2s = 32;
                        U.v = (const bf16_t*)(ws + WS_KV) + row0 * 1024 + h * 128 + 64; U.vs = 1024;
                        U.o = (bf16_t*)(ws + WS_OA) + (row0 + 256 * qb) * 512 + h * 64; U.os = 512;
                        U.t0 = 0; U.t1 = 64;
                        attn_unit<0>(lds, U, relb);
                    } else {
                        const int v = u - 1024, u16 = v & 15, g = (v >> 4) % 3, bh = (v >> 4) / 3, h = bh & 3, b = bh >> 2;
                        const int dil = g == 0 ? 1 : (g == 1 ? 4 : 16), L = SEQ / dil, nblk = L / 256, rr = u16 / nblk, nb = u16 % nblk;
                        const long base = (long)b * SEQ + rr, qrow0 = base + (long)256 * nb * dil;
                        U.q = (const bf16_t*)(ws + WS_DQ) + qrow0 * 768 + (g * 4 + h) * 64; U.qs = 768L * dil;
                        U.k = (const bf16_t*)(ws + WS_DK) + base * 768 + (g * 4 + h) * 64; U.ks = 768L * dil; U.k2 = U.k; U.k2s = 0;
                        U.v = (const bf16_t*)(ws + WS_DV) + base * 512 + h * 128; U.vs = 512L * dil;
                        U.o = (bf16_t*)(ws + WS_PB) + ((long)g * MC + qrow0) * 512 + h * 128; U.os = 512L * dil;
                        U.lse = (float*)(ws + WS_LSE) + ((long)g * MC + qrow0) * 4 + h; U.lses = 4L * dil;
                        U.t0 = max(0, 4 * nb - 1); U.t1 = min(L / 64, 4 * nb + 5); U.tq0 = 256 * nb; U.dil = dil; U.bcol = g * 4 + h;
                        attn_unit<2>(lds, U, relb);
                    }
                }
            }
            else if (kind == 3) {
                const float a1 = wave_sum(p.in[I_LQ1][l * 64 + lane] * p.in[I_LK1][l * 64 + lane]), a2 = wave_sum(p.in[I_LQ2][l * 64 + lane] * p.in[I_LK2][l * 64 + lane]);
                const float lam_init = p.lam_init[l], lam = expf(a1) - expf(a2) + lam_init, osc = 1.f - lam_init;
                const bf16_t* PB = (const bf16_t*)(ws + WS_PB); const float* LSE = (const float*)(ws + WS_LSE);
                bf16_t* OB = (bf16_t*)(ws + WS_OA) + (size_t)MC * 512; bf16_t* OC = OB + (size_t)MC * 512;
                const float* gs = p.in[I_GDIFF] + l * 128 + (lane & 15) * 8;
                const f32x4 gs0 = *(const f32x4*)gs, gs1 = *(const f32x4*)(gs + 4);
                for (int r = gw; r < MC; r += NGW) {
                    const int h = lane >> 4;
                    const float l0 = LSE[(size_t)r * 4 + h], l1 = LSE[((size_t)MC + r) * 4 + h], l2 = LSE[((size_t)2 * MC + r) * 4 + h];
                    const float mx = fmaxf(l0, fmaxf(l1, l2));
                    float w0 = __builtin_amdgcn_exp2f(l0 - mx), w1 = __builtin_amdgcn_exp2f(l1 - mx), w2 = __builtin_amdgcn_exp2f(l2 - mx);
                    const float wi = 1.f / (w0 + w1 + w2); w0 *= wi; w1 *= wi; w2 *= wi;
                    const u32x4 x0 = *(const u32x4*)(PB + (size_t)r * 512 + lane * 8), x1 = *(const u32x4*)(PB + ((size_t)MC + r) * 512 + lane * 8), x2 = *(const u32x4*)(PB + ((size_t)2 * MC + r) * 512 + lane * 8);
                    u32x4 ob;
#pragma unroll
                    for (int e = 0; e < 4; ++e) ob[e] = pk2(w0 * bflo(x0[e]) + w1 * bflo(x1[e]) + w2 * bflo(x2[e]), w0 * bfhi(x0[e]) + w1 * bfhi(x1[e]) + w2 * bfhi(x2[e]));
                    *(u32x4*)(OB + (size_t)r * 512 + lane * 8) = ob;
                    const u32x4 c0 = *(const u32x4*)(XN + (size_t)r * 512 + lane * 8), c1 = *(const u32x4*)(XN + ((size_t)MC + r) * 512 + lane * 8);
                    float d[8]; float ss = 0.f;
#pragma unroll
                    for (int e = 0; e < 4; ++e) { d[2 * e] = bflo(c0[e]) - lam * bflo(c1[e]); d[2 * e + 1] = bfhi(c0[e]) - lam * bfhi(c1[e]); ss += d[2 * e] * d[2 * e] + d[2 * e + 1] * d[2 * e + 1]; }
                    ss += __shfl_xor(ss, 1); ss += __shfl_xor(ss, 2); ss += __shfl_xor(ss, 4); ss += __shfl_xor(ss, 8);
                    const float rs = osc / sqrtf(ss * (1.f / 128.f) + EPS);
                    u32x4 oc; oc.x = pk2(d[0] * rs * gs0[0], d[1] * rs * gs0[1]); oc.y = pk2(d[2] * rs * gs0[2], d[3] * rs * gs0[3]); oc.z = pk2(d[4] * rs * gs1[0], d[5] * rs * gs1[1]); oc.w = pk2(d[6] * rs * gs1[2], d[7] * rs * gs1[3]);
                    *(u32x4*)(OC + (size_t)r * 512 + lane * 8) = oc;
                }
            }
            else if (kind == 4) {
                pg8::Gemm g{(const bf16_t*)(ws + WS_OA), (const bf16_t*)(ws + WS_WBR), 3 * MC, 3 * DM, 512, 512, 512}; MergeOrder S{G, (int)blockIdx.x};
                EpiMerge E{ws, XN}; pg8::gemm_phase<EpiMerge, MergeOrder, true, true>(lds, g, S, E);
            }
            else if (kind == 5) {
                pg8::Gemm g{XN, (const bf16_t*)(ws + WS_WOUT), MC, DM, DM, DM, DM}; pg8::StaticOrder S; S.init(MC, DM, G, (int)blockIdx.x);
                EpiF32 E{ws}; pg8::gemm_phase<EpiF32, pg8::StaticOrder, true, true>(lds, g, S, E);
            }
            else if (kind == 6) {
                const float* xsrc = (l == 0 ? p.in[I_X] : p.out) + (size_t)tok0 * DM; float* xdst = p.out + (size_t)tok0 * DM;
                for (int r = gw; r < MC; r += NGW)
                    norm_row(xsrc + (size_t)r * DM, xdst + (size_t)r * DM, (const float*)(ws + WS_Y) + (size_t)r * DM, (const float*)(ws + WS_SSY) + r * 16, p.in[I_GMIXPOST] + l * DM, p.in[I_GMLPPRE] + l * DM, XN + (size_t)r * DM, lane);
            }
            else if (kind == 7) {
                pg8::Gemm g{XN, (const bf16_t*)(ws + WS_WUP), MC, FF, DM, DM, DM}; pg8::StaticOrder S; S.init(MC, FF, G, (int)blockIdx.x);
                EpiUp E{ws}; pg8::gemm_phase<EpiUp, pg8::StaticOrder, true, true>(lds, g, S, E);
            }
            else if (kind == 8) {
                pg8::Gemm g{(const bf16_t*)(ws + WS_U), (const bf16_t*)(ws + WS_WDN), MC, DM, FF, FF, FF}; pg8::StaticOrder S; S.init(MC, DM, G, (int)blockIdx.x);
                EpiF32 E{ws}; pg8::gemm_phase<EpiF32, pg8::StaticOrder, true, true>(lds, g, S, E);
            }
            else if (kind == 9) {
                float* xdst = p.out + (size_t)tok0 * DM; const bool lastl = l == DEPTH - 1;
                for (int r = gw; r < MC; r += NGW)
                    norm_row(xdst + (size_t)r * DM, xdst + (size_t)r * DM, (const float*)(ws + WS_Y) + (size_t)r * DM, (const float*)(ws + WS_SSY) + r * 16, p.in[I_GMLPPOST] + l * DM,
                             lastl ? nullptr : p.in[I_GMIXPRE] + (l + 1) * DM, lastl ? nullptr : XN + (size_t)r * DM, lane);
                if (c == NCHUNK - 1 && !lastl) { __syncthreads(); convert_layer(p, l + 1, lds, gw, NGW, wave, lane); }
            }
    }
    if (ph + 1 < p.ph_hi) grid.sync();
    }
}

constexpr int N_PHASES = 1 + DEPTH * NCHUNK * 10;
extern "C" void kernel_launch(void* const* d_in, const int* in_sizes, int n_in, void* d_out, int out_size, void* d_ws, size_t ws_size, hipStream_t stream) {
    static int grid = 0;
    if (grid == 0) {
        if (n_in != 21 || out_size != MALL * DM || ws_size < WS_END) { fprintf(stderr, "kernel_launch: unexpected shapes (n_in %d out %d ws %zu)\n", n_in, out_size, ws_size); grid = -1; return; }
        int dev = 0, cus = 0, per_cu = 0;
        (void)hipGetDevice(&dev); (void)hipDeviceGetAttribute(&cus, hipDeviceAttributeMultiprocessorCount, dev);
        (void)hipFuncSetAttribute((const void*)fwd_megakernel, hipFuncAttributeMaxDynamicSharedMemorySize, LDS_BYTES);
        (void)hipOccupancyMaxActiveBlocksPerMultiprocessor(&per_cu, (const void*)fwd_megakernel, 512, LDS_BYTES);
        if (per_cu < 1) per_cu = 1;
        grid = cus * per_cu;
    }
    if (grid < 0) return;
    Params p{};
    for (int i = 0; i < 21; ++i) p.in[i] = (const float*)d_in[i];
    p.out = (float*)d_out; p.ws = (unsigned char*)d_ws;
    for (int i = 0; i < 16; ++i) p.inv[i] = pow(10000.0, -(double)i / 16.0);
    for (int l = 0; l < 4; ++l) p.lam_init[l] = (float)(0.8 - 0.6 * exp(-0.3 * (double)l));
    p.ph_lo = 0; p.ph_hi = N_PHASES;
    void* args[] = {&p};
    hipError_t e = hipLaunchCooperativeKernel((const void*)fwd_megakernel, dim3(grid), dim3(512), args, LDS_BYTES, stream);
    if (e != hipSuccess) fprintf(stderr, "cooperative launch failed: %s (grid %d)\n", hipGetErrorString(e), grid);
}
```

```cpp
#include <hip/hip_runtime.h>
#include <hip/hip_cooperative_groups.h>
#include <cstdio>
#include <cstdint>
#include <cmath>
namespace cg = cooperative_groups;

#define LAS __attribute__((address_space(3)))
typedef float f32x2 __attribute__((ext_vector_type(2)));
typedef float f32x16 __attribute__((ext_vector_type(16)));
typedef unsigned u32x2 __attribute__((ext_vector_type(2)));
typedef short s16x4 __attribute__((ext_vector_type(4)));
typedef __bf16 bf16x2_t __attribute__((ext_vector_type(2)));
__device__ __forceinline__ unsigned pk2(float lo, float hi) { f32x2 v = {lo, hi}; bf16x2_t b = __builtin_convertvector(v, bf16x2_t); return __builtin_bit_cast(unsigned, b); }
__device__ __forceinline__ float bflo(unsigned w) { return __uint_as_float(w << 16); }
__device__ __forceinline__ float bfhi(unsigned w) { return __uint_as_float(w & 0xffff0000u); }
__device__ __forceinline__ float wave_sum(float v) {
#pragma unroll
    for (int o = 1; o < 64; o <<= 1) v += __shfl_xor(v, o);
    return v;
}

constexpr int DM = 1024, SEQ = 4096, BATCH = 8, DEPTH = 4, MALL = BATCH * SEQ, CB = 4, MC = CB * SEQ, NCHUNK = 2;
constexpr int NZ = 7168, FF = 4096, INC = 7072;
constexpr float EPS = 1e-6f, LOG2E = 1.4426950408889634f;
constexpr size_t MiB = 1u << 20;
constexpr size_t WS_SSQ = 1 * MiB, WS_SSKV = 1 * MiB + 512 * 1024, WS_SSY = 2 * MiB, WS_LSE = 3 * MiB, WS_TMM = 3 * MiB + 800 * 1024;
constexpr size_t WS_ROPE = 4 * MiB;
constexpr size_t WS_WIN = 8 * MiB, WS_WUQ = 22 * MiB, WS_WUKV = 22 * MiB + 512 * 1024, WS_WBR = 23 * MiB, WS_WOUT = 26 * MiB, WS_WUP = 28 * MiB, WS_WDN = 36 * MiB;
constexpr size_t WS_XN = 44 * MiB;
constexpr size_t WS_G = 108 * MiB;
constexpr size_t WS_CQ = 204 * MiB, WS_CKV = 212 * MiB, WS_KR = 216 * MiB;
constexpr size_t WS_DQ = 218 * MiB, WS_DK = 242 * MiB, WS_DV = 266 * MiB, WS_FQ = 282 * MiB, WS_FK = 298 * MiB, WS_FV = 314 * MiB;
constexpr size_t WS_Q = 330 * MiB, WS_KV = 354 * MiB;
constexpr size_t WS_OA = 386 * MiB;
constexpr size_t WS_PB = 434 * MiB;
constexpr size_t WS_END = 482 * MiB;
constexpr size_t WS_U = 108 * MiB;
constexpr size_t WS_Y = 236 * MiB;
namespace pg8 {
#define PG8_LAS __attribute__((address_space(3)))
typedef unsigned short bf16_t;
typedef short bf16x8 __attribute__((ext_vector_type(8)));
typedef float f32x4 __attribute__((ext_vector_type(4)));
typedef unsigned u32x4 __attribute__((ext_vector_type(4)));
constexpr int BM = 256, BK = 64, HALF = 128, HTB = HALF * BK * 2  , STAGE_BYTES = 8 * HTB, NXCD = 8, WGM = 8;

__host__ __device__ __forceinline__ int lds_byte(int r, int c) { const int st = (r >> 4) * 2 + (c >> 5), rr = r & 15, cc = c & 31, ob = rr * 64 + cc * 2; return st * 1024 + (ob ^ (((ob >> 9) & 1) << 5)); }
__host__ __device__ __forceinline__ void stage_rc(int b, int& R, int& C) { const int st = b / 1024, sb = b % 1024, swz = sb ^ (((sb >> 9) & 1) << 5); R = (st >> 1) * 16 + swz / 64; C = (st & 1) * 32 + (swz % 64) / 2; }
__host__ __device__ __forceinline__ int perm32(int rho) { const int n = rho >> 4, i = rho & 15; return 8 * (i >> 2) + 4 * n + (i & 3); }

struct Unit { int pm, pn; };
struct Gemm { const bf16_t* A; const bf16_t* Bt; int M, N, K, lda, ldb; };

struct StaticOrder {
    int nM, nN, nwg, G, c;
    __host__ __device__ void init(int M, int N, int G_, int c_) { nM = M / BM; nN = N / BM; nwg = nM * nN; G = G_; c = c_; }
    __host__ __device__ bool next(int i, Unit& u) const {
        const long L = (long)i * G + c; if (L >= nwg) return false;
        int wgid = (int)L; { const int q = nwg / NXCD, r = nwg % NXCD, xcd = wgid % NXCD, off = wgid / NXCD; wgid = (xcd < r ? xcd * (q + 1) : r * (q + 1) + (xcd - r) * q) + off; }
        const int nig = WGM * nN, gid = wgid / nig, fm = gid * WGM, gsz = (nM - fm) < WGM ? (nM - fm) : WGM;
        u.pm = fm + ((wgid % nig) % gsz); u.pn = (wgid % nig) / gsz; return true;
    }
    __device__ __forceinline__ void a_ready(const Unit&) const {}
    __device__ __forceinline__ void done(const Unit&) const {}
};


template <class Epi, class Sched, bool ALIGN_EPI = false, bool SP2 = false>
__device__ __forceinline__ void gemm_phase(PG8_LAS unsigned char* lds, const Gemm g, const Sched& S, const Epi& E) {
    int tid = threadIdx.x; asm volatile("" : "+v"(tid));
    const int wid = __builtin_amdgcn_readfirstlane(tid >> 6), lane = tid & 63, wr = wid >> 2, wc = wid & 3, fr = lane & 15, fq = lane >> 4;
    int K = g.K; asm volatile("" : "+s"(K)); const int nt = K / BK;
    unsigned voffA[2], voffB[2];
#pragma unroll
    for (int i = 0; i < 2; ++i) { int R, C; stage_rc(tid * 16 + i * 8192, R, C); const int Rb = Epi::PERM ? ((R & ~31) + perm32(R & 31)) : R;
        voffA[i] = (unsigned)(R * g.lda + C) * 2u; voffB[i] = (unsigned)(Rb * g.ldb + C) * 2u; }
    const size_t kstep = (size_t)(BK * 2);
    const size_t hstepA = (size_t)HALF * g.lda * 2, hstepB = (size_t)HALF * g.ldb * 2;
    const size_t tstepA = 2 * hstepA, tstepB = 2 * hstepB;
    const unsigned ldsw = (unsigned)wid * 1024u;
    const int aoff = lds_byte(wr * 64 + fr, fq * 8), boff = lds_byte(wc * 32 + fr, fq * 8);
#define PG8_SA(b, h) (((b) * 2 + (h)) * HTB)
#define PG8_SB(b, h) ((4 + (b) * 2 + (h)) * HTB)
#define PG8_STAGE(bufoff, gbase, voff) do { _Pragma("unroll") for (int _i = 0; _i < 2; ++_i) \
        __builtin_amdgcn_global_load_lds((const unsigned*)((const char*)(gbase) + (voff)[_i]), (PG8_LAS unsigned*)(lds + (bufoff) + ldsw + _i * 8192), 16, 0, 0); } while (0)
#define PG8_LDA(dst, b, h) do { _Pragma("unroll") for (int m = 0; m < 4; ++m) _Pragma("unroll") for (int k = 0; k < 2; ++k) dst[m][k] = *(const PG8_LAS bf16x8*)(lds + PG8_SA(b, h) + aoff + m * 2048 + k * 1024); } while (0)
#define PG8_LDB(dst, b, h) do { _Pragma("unroll") for (int n = 0; n < 2; ++n) _Pragma("unroll") for (int k = 0; k < 2; ++k) dst[n][k] = *(const PG8_LAS bf16x8*)(lds + PG8_SB(b, h) + boff + n * 2048 + k * 1024); } while (0)
#define PG8_MMA(ai, bj, At, Bt) do { __builtin_amdgcn_s_setprio(1); _Pragma("unroll") for (int m = 0; m < 4; ++m) _Pragma("unroll") for (int n = 0; n < 2; ++n) _Pragma("unroll") for (int k = 0; k < 2; ++k) \
        acc[ai][bj][m][n] = __builtin_amdgcn_mfma_f32_16x16x32_bf16(Bt[n][k], At[m][k], acc[ai][bj][m][n], 0, 0, 0); __builtin_amdgcn_s_setprio(0); } while (0)
#define PG8_WAIT_V(n) asm volatile("s_waitcnt vmcnt(" #n ")" ::: "memory")
#define PG8_WAIT_L(n) asm volatile("s_waitcnt lgkmcnt(" #n ")" ::: "memory")
#define PG8_BAR __builtin_amdgcn_s_barrier()
#define PG8_SCHED __builtin_amdgcn_sched_barrier(0)
    Unit cur, nxt; int ui = 0;
    if (!S.next(0, cur)) return;
    f32x4 acc[2][2][4][2];
#pragma unroll
    for (int a = 0; a < 2; ++a)
#pragma unroll
        for (int b = 0; b < 2; ++b)
#pragma unroll
            for (int m = 0; m < 4; ++m)
#pragma unroll
                for (int n = 0; n < 2; ++n) acc[a][b][m][n] = (f32x4){0.f, 0.f, 0.f, 0.f};
    bf16x8 At[4][2], B0[2][2], B1[2][2];
    const char* cA = (const char*)g.A + (size_t)cur.pm * tstepA; const char* cB = (const char*)g.Bt + (size_t)cur.pn * tstepB;
    S.a_ready(cur);
    if constexpr (SP2) {
        PG8_STAGE(PG8_SB(0, 0), cB, voffB); PG8_STAGE(PG8_SB(0, 1), cB + hstepB, voffB); PG8_STAGE(PG8_SA(0, 0), cA, voffA); PG8_STAGE(PG8_SA(0, 1), cA + hstepA, voffA);
        if (wr == 1) PG8_BAR;
        PG8_WAIT_V(2); PG8_BAR;
        PG8_STAGE(PG8_SB(1, 0), cB + kstep, voffB); PG8_STAGE(PG8_SA(1, 0), cA + kstep, voffA); PG8_STAGE(PG8_SB(1, 1), cB + hstepB + kstep, voffB);
        PG8_WAIT_V(6); PG8_BAR;
    } else {
        PG8_STAGE(PG8_SB(0, 0), cB, voffB); PG8_STAGE(PG8_SA(0, 0), cA, voffA); PG8_STAGE(PG8_SB(0, 1), cB + hstepB, voffB); PG8_STAGE(PG8_SA(0, 1), cA + hstepA, voffA);
        if (wr == 1) PG8_BAR;
        PG8_WAIT_V(4); PG8_BAR;
        PG8_STAGE(PG8_SB(1, 0), cB + kstep, voffB); PG8_STAGE(PG8_SA(1, 0), cA + kstep, voffA); PG8_STAGE(PG8_SB(1, 1), cB + hstepB + kstep, voffB);
        PG8_WAIT_V(6); PG8_BAR;
    }
    for (;;) {
        const bool has_next = S.next(ui + 1, nxt);
        const char* nA = has_next ? (const char*)g.A + (size_t)nxt.pm * tstepA : cA; const char* nB = has_next ? (const char*)g.Bt + (size_t)nxt.pn * tstepB : cB;
        for (int t = 0; t < nt; t += 2) {
            const bool last = (t == nt - 2);
            const char* a1 = cA + (size_t)(t + 1) * kstep;
            const char* a2 = last ? nA : cA + (size_t)(t + 2) * kstep; const char* b2 = last ? nB : cB + (size_t)(t + 2) * kstep;
            const char* a3 = a2 + kstep; const char* b3 = b2 + kstep;
            if (last && has_next) S.a_ready(nxt);
            if constexpr (SP2) {
            PG8_LDB(B0, 0, 0); PG8_LDB(B1, 0, 1); PG8_SCHED; PG8_LDA(At, 0, 0); PG8_STAGE(PG8_SA(1, 1), a1 + hstepA, voffA);
            PG8_WAIT_V(8); PG8_WAIT_L(0); PG8_BAR; PG8_MMA(0, 0, At, B0); PG8_MMA(0, 1, At, B1); PG8_BAR; PG8_SCHED;
            PG8_LDA(At, 0, 1); PG8_STAGE(PG8_SB(0, 0), b2, voffB); PG8_STAGE(PG8_SB(0, 1), b2 + hstepB, voffB); PG8_STAGE(PG8_SA(0, 0), a2, voffA);
            PG8_WAIT_V(8); PG8_WAIT_L(0); PG8_BAR; PG8_MMA(1, 0, At, B0); PG8_MMA(1, 1, At, B1); PG8_BAR; PG8_SCHED;
            PG8_LDB(B0, 1, 0); PG8_LDB(B1, 1, 1); PG8_SCHED; PG8_LDA(At, 1, 0); PG8_STAGE(PG8_SA(0, 1), a2 + hstepA, voffA);
            PG8_WAIT_V(8); PG8_WAIT_L(0); PG8_BAR; PG8_MMA(0, 0, At, B0); PG8_MMA(0, 1, At, B1); PG8_BAR; PG8_SCHED;
            PG8_LDA(At, 1, 1); PG8_STAGE(PG8_SB(1, 0), b3, voffB); PG8_STAGE(PG8_SB(1, 1), b3 + hstepB, voffB); PG8_STAGE(PG8_SA(1, 0), a3, voffA);
            PG8_WAIT_V(8); PG8_WAIT_L(0); PG8_BAR; PG8_MMA(1, 0, At, B0); PG8_MMA(1, 1, At, B1); PG8_BAR; PG8_SCHED;
            } else {
            PG8_LDB(B0, 0, 0); PG8_SCHED; PG8_LDA(At, 0, 0); PG8_STAGE(PG8_SA(1, 1), a1 + hstepA, voffA);
            PG8_WAIT_L(8); PG8_BAR; PG8_WAIT_L(0); PG8_MMA(0, 0, At, B0); PG8_BAR; PG8_SCHED;
            PG8_LDB(B1, 0, 1); PG8_STAGE(PG8_SB(0, 0), b2, voffB);
            PG8_BAR; PG8_WAIT_L(0); PG8_MMA(0, 1, At, B1); PG8_BAR;
            PG8_LDA(At, 0, 1); PG8_STAGE(PG8_SA(0, 0), a2, voffA);
            PG8_BAR; PG8_WAIT_L(0); PG8_MMA(1, 0, At, B0); PG8_BAR; PG8_SCHED;
            PG8_STAGE(PG8_SB(0, 1), b2 + hstepB, voffB);
            PG8_WAIT_V(6); PG8_BAR; PG8_MMA(1, 1, At, B1); PG8_BAR;
            PG8_LDB(B0, 1, 0); PG8_SCHED; PG8_LDA(At, 1, 0); PG8_STAGE(PG8_SA(0, 1), a2 + hstepA, voffA);
            PG8_WAIT_L(8); PG8_BAR; PG8_WAIT_L(0); PG8_MMA(0, 0, At, B0); PG8_BAR; PG8_SCHED;
            PG8_LDB(B1, 1, 1); PG8_STAGE(PG8_SB(1, 0), b3, voffB);
            PG8_BAR; PG8_WAIT_L(0); PG8_MMA(0, 1, At, B1); PG8_BAR;
            PG8_LDA(At, 1, 1); PG8_STAGE(PG8_SA(1, 0), a3, voffA);
            PG8_BAR; PG8_WAIT_L(0); PG8_MMA(1, 0, At, B0); PG8_BAR; PG8_SCHED;
            PG8_STAGE(PG8_SB(1, 1), b3 + hstepB, voffB);
            PG8_WAIT_V(6); PG8_BAR; PG8_MMA(1, 1, At, B1); PG8_BAR;
            }
        }
        if constexpr (ALIGN_EPI) { if (wr == 0) PG8_BAR; }
        if constexpr (!Epi::AFTER_DRAIN) { E(acc, cur, wr, wc, fr, fq); S.done(cur); }
        if (!has_next) break;
#pragma unroll
        for (int a = 0; a < 2; ++a)
#pragma unroll
            for (int b = 0; b < 2; ++b)
#pragma unroll
                for (int m = 0; m < 4; ++m)
#pragma unroll
                    for (int n = 0; n < 2; ++n) acc[a][b][m][n] = (f32x4){0.f, 0.f, 0.f, 0.f};
        cur = nxt; cA = nA; cB = nB; ++ui;
        if constexpr (ALIGN_EPI) { if (wr == 1) PG8_BAR; }
    }
    PG8_WAIT_V(0);
    if constexpr (!ALIGN_EPI) { if (wr == 0) PG8_BAR; }
    PG8_BAR;
    if constexpr (Epi::AFTER_DRAIN) { E.fused(acc, cur, wr, wc, fr, fq, lds, wid, lane); S.done(cur); }
#undef PG8_SA
#undef PG8_SB
#undef PG8_STAGE
#undef PG8_LDA
#undef PG8_LDB
#undef PG8_MMA
#undef PG8_WAIT_V
#undef PG8_WAIT_L
#undef PG8_BAR
#undef PG8_SCHED
}
}

using pg8::bf16_t; using pg8::f32x4; using pg8::u32x4; using pg8::bf16x8;
constexpr float QSCALE_MLA = 0.10206207261596575f * LOG2E;
constexpr float QSCALE_64 = 0.125f * LOG2E;
__device__ __forceinline__ float sigmoidf_fast(float v) { return __builtin_amdgcn_rcpf(1.f + __builtin_amdgcn_exp2f(-v * LOG2E)); }
__device__ __forceinline__ u32x4 pack8(const f32x4 a, const f32x4 b) { u32x4 w; w.x = pk2(a[0], a[1]); w.y = pk2(a[2], a[3]); w.z = pk2(b[0], b[1]); w.w = pk2(b[2], b[3]); return w; }
__device__ __forceinline__ void rope8(f32x4& a, f32x4& b, const f32x4 c, const f32x4 s) {
    f32x4 ra, rb;
    ra[0] = a[0] * c[0] - a[1] * s[0]; ra[1] = a[1] * c[0] + a[0] * s[0];
    ra[2] = a[2] * c[1] - a[3] * s[1]; ra[3] = a[3] * c[1] + a[2] * s[1];
    rb[0] = b[0] * c[2] - b[1] * s[2]; rb[1] = b[1] * c[2] + b[0] * s[2];
    rb[2] = b[2] * c[3] - b[3] * s[3]; rb[3] = b[3] * c[3] + b[2] * s[3];
    a = ra; b = rb;
}

struct EpiZ {
    static constexpr bool PERM = true, AFTER_DRAIN = false;
    unsigned char* ws; const float* rope; int tok0;
    __device__ __forceinline__ void operator()(const f32x4 (&acc)[2][2][4][2], const pg8::Unit& u, int wr, int wc, int fr, int fq) const {
        const int pn = u.pn, row0 = u.pm * 256 + wr * 64 + fr, cl = wc * 32 + 8 * fq;
        if (pn == 12) {
            bf16_t* CQ = (bf16_t*)(ws + WS_CQ); float* SSQ = (float*)(ws + WS_SSQ);
#pragma unroll
            for (int ai = 0; ai < 2; ++ai)
#pragma unroll
                for (int m = 0; m < 4; ++m) { const int r = row0 + ai * 128 + m * 16; float s = 0.f;
#pragma unroll
                    for (int bj = 0; bj < 2; ++bj) { const f32x4 v0 = acc[ai][bj][m][0], v1 = acc[ai][bj][m][1];
                        s += (v0[0] * v0[0] + v0[1] * v0[1]) + (v0[2] * v0[2] + v0[3] * v0[3]) + (v1[0] * v1[0] + v1[1] * v1[1]) + (v1[2] * v1[2] + v1[3] * v1[3]);
                        *(u32x4*)(CQ + (size_t)r * 256 + bj * 128 + cl) = pack8(v0, v1); }
                    s += __shfl_xor(s, 16); s += __shfl_xor(s, 32);
                    if (fq == 0) SSQ[r * 4 + wc] = s; }
        } else if (pn == 13) {
            bf16_t* CKV = (bf16_t*)(ws + WS_CKV); bf16_t* KR = (bf16_t*)(ws + WS_KR); float* SSKV = (float*)(ws + WS_SSKV);
#pragma unroll
            for (int ai = 0; ai < 2; ++ai)
#pragma unroll
                for (int m = 0; m < 4; ++m) { const int r = row0 + ai * 128 + m * 16;
                    const f32x4 v0 = acc[ai][0][m][0], v1 = acc[ai][0][m][1];
                    float s = (v0[0] * v0[0] + v0[1] * v0[1]) + (v0[2] * v0[2] + v0[3] * v0[3]) + (v1[0] * v1[0] + v1[1] * v1[1]) + (v1[2] * v1[2] + v1[3] * v1[3]);
                    *(u32x4*)(CKV + (size_t)r * 128 + cl) = pack8(v0, v1);
                    s += __shfl_xor(s, 16); s += __shfl_xor(s, 32);
                    if (fq == 0) SSKV[r * 4 + wc] = s;
                    if (wc == 0) { f32x4 a = acc[ai][1][m][0], b = acc[ai][1][m][1];
                        const float* rp = rope + (size_t)(tok0 + r) * 32 + 4 * fq;
                        rope8(a, b, *(const f32x4*)rp, *(const f32x4*)(rp + 16));
                        *(u32x4*)(KR + (size_t)r * 32 + 8 * fq) = pack8(a, b); }
                    asm volatile("" ::: "memory"); }
        } else {
            bf16_t* base; int ldc, col; float sc = 1.f; const bool sig = pn < 12;
            if (pn < 12) { base = (bf16_t*)(ws + WS_G); ldc = 3072; col = pn * 256; }
            else if (pn < 17) { base = (bf16_t*)(ws + WS_DQ); ldc = 768; col = (pn - 14) * 256; sc = QSCALE_64; }
            else if (pn < 20) { base = (bf16_t*)(ws + WS_DK); ldc = 768; col = (pn - 17) * 256; }
            else if (pn < 22) { base = (bf16_t*)(ws + WS_DV); ldc = 512; col = (pn - 20) * 256; }
            else if (pn < 24) { base = (bf16_t*)(ws + WS_FQ); ldc = 512; col = (pn - 22) * 256; sc = QSCALE_64; }
            else if (pn < 26) { base = (bf16_t*)(ws + WS_FK); ldc = 512; col = (pn - 24) * 256; }
            else { base = (bf16_t*)(ws + WS_FV); ldc = 512; col = (pn - 26) * 256; }
#pragma unroll
            for (int ai = 0; ai < 2; ++ai)
#pragma unroll
                for (int m = 0; m < 4; ++m) { bf16_t* rowp = base + (size_t)(row0 + ai * 128 + m * 16) * ldc + col + cl;
#pragma unroll
                    for (int bj = 0; bj < 2; ++bj) { f32x4 v0 = acc[ai][bj][m][0] * sc, v1 = acc[ai][bj][m][1] * sc;
                        if (sig) {
#pragma unroll
                            for (int e = 0; e < 4; ++e) { v0[e] = sigmoidf_fast(v0[e]); v1[e] = sigmoidf_fast(v1[e]); } }
                        *(u32x4*)(rowp + bj * 128) = pack8(v0, v1); } }
        }
    }
};

struct EpiUpQ {
    static constexpr bool PERM = true, AFTER_DRAIN = false;
    unsigned char* ws; const float* rope; int tok0;
    __device__ __forceinline__ void operator()(const f32x4 (&acc)[2][2][4][2], const pg8::Unit& u, int wr, int wc, int fr, int fq) const {
        bf16_t* Q = (bf16_t*)(ws + WS_Q); const float* SSQ = (const float*)(ws + WS_SSQ);
        const int row0 = u.pm * 256 + wr * 64 + fr, cl = wc * 32 + 8 * fq;
#pragma unroll
        for (int ai = 0; ai < 2; ++ai)
#pragma unroll
            for (int m = 0; m < 4; ++m) { const int r = row0 + ai * 128 + m * 16;
                const f32x4 ss = *(const f32x4*)(SSQ + r * 4);
                const float rs = QSCALE_MLA * __builtin_amdgcn_rsqf(((ss[0] + ss[1]) + (ss[2] + ss[3])) * (1.f / 256.f) + EPS);
#pragma unroll
                for (int bj = 0; bj < 2; ++bj) { f32x4 a = acc[ai][bj][m][0] * rs, b = acc[ai][bj][m][1] * rs;
                    const int slab = u.pn * 8 + bj * 4 + wc;
                    if (slab % 3 == 2) { const float* rp = rope + (size_t)(tok0 + r) * 32 + 4 * fq; rope8(a, b, *(const f32x4*)rp, *(const f32x4*)(rp + 16)); }
                    *(u32x4*)(Q + (size_t)r * 768 + u.pn * 256 + bj * 128 + cl) = pack8(a, b); }
                asm volatile("" ::: "memory"); }
    }
};
struct EpiUpKV {
    static constexpr bool PERM = true, AFTER_DRAIN = false;
    unsigned char* ws;
    __device__ __forceinline__ void operator()(const f32x4 (&acc)[2][2][4][2], const pg8::Unit& u, int wr, int wc, int fr, int fq) const {
        bf16_t* KV = (bf16_t*)(ws + WS_KV); const float* SS = (const float*)(ws + WS_SSKV);
        const int row0 = u.pm * 256 + wr * 64 + fr, cl = wc * 32 + 8 * fq;
#pragma unroll
        for (int ai = 0; ai < 2; ++ai)
#pragma unroll
            for (int m = 0; m < 4; ++m) { const int r = row0 + ai * 128 + m * 16;
                const f32x4 ss = *(const f32x4*)(SS + r * 4);
                const float rs = __builtin_amdgcn_rsqf(((ss[0] + ss[1]) + (ss[2] + ss[3])) * (1.f / 128.f) + EPS);
#pragma unroll
                for (int bj = 0; bj < 2; ++bj) *(u32x4*)(KV + (size_t)r * 1024 + u.pn * 256 + bj * 128 + cl) = pack8(acc[ai][bj][m][0] * rs, acc[ai][bj][m][1] * rs);
                asm volatile("" ::: "memory"); }
    }
};
struct EpiMerge {
    static constexpr bool PERM = true, AFTER_DRAIN = false;
    unsigned char* ws; bf16_t* MG;
    __device__ __forceinline__ void operator()(const f32x4 (&acc)[2][2][4][2], const pg8::Unit& u, int wr, int wc, int fr, int fq) const {
        const bf16_t* G = (const bf16_t*)(ws + WS_G); float* T = (float*)(ws + WS_Y);
        const int b = u.pm >> 6, pml = u.pm & 63, pnl = u.pn & 3;
        const int row0 = pml * 256 + wr * 64 + fr, col0 = pnl * 256 + wc * 32 + 8 * fq;
#pragma unroll
        for (int ai = 0; ai < 2; ++ai)
#pragma unroll
            for (int m = 0; m < 4; ++m) { const int r = row0 + ai * 128 + m * 16;
#pragma unroll
                for (int bj = 0; bj < 2; ++bj) { const int c = col0 + bj * 128;
                    const u32x4 gw = *(const u32x4*)(G + (size_t)r * 3072 + b * 1024 + c);
                    f32x4 g0 = {bflo(gw.x), bfhi(gw.x), bflo(gw.y), bfhi(gw.y)}, g1 = {bflo(gw.z), bfhi(gw.z), bflo(gw.w), bfhi(gw.w)};
                    f32x4 v0 = acc[ai][bj][m][0] * g0, v1 = acc[ai][bj][m][1] * g1;
                    float* tp = T + (size_t)r * 1024 + c;
                    if (b > 0) { v0 += *(const f32x4*)tp; v1 += *(const f32x4*)(tp + 4); }
                    if (b < 2) { *(f32x4*)tp = v0; *(f32x4*)(tp + 4) = v1; }
                    else *(u32x4*)(MG + (size_t)r * 1024 + c) = pack8(v0, v1); }
                asm volatile("" ::: "memory"); }
    }
};
struct EpiF32 {
    static constexpr bool PERM = false, AFTER_DRAIN = false;
    unsigned char* ws;
    __device__ __forceinline__ void operator()(const f32x4 (&acc)[2][2][4][2], const pg8::Unit& u, int wr, int wc, int fr, int fq) const {
        float* Y = (float*)(ws + WS_Y); float* SS = (float*)(ws + WS_SSY);
        const int row0 = u.pm * 256 + wr * 64 + fr, col0 = u.pn * 256 + wc * 32 + 4 * fq;
#pragma unroll
        for (int ai = 0; ai < 2; ++ai)
#pragma unroll
            for (int m = 0; m < 4; ++m) { const int r = row0 + ai * 128 + m * 16; float s = 0.f;
#pragma unroll
                for (int bj = 0; bj < 2; ++bj)
#pragma unroll
                    for (int n = 0; n < 2; ++n) { const f32x4 v = acc[ai][bj][m][n]; s += (v[0] * v[0] + v[1] * v[1]) + (v[2] * v[2] + v[3] * v[3]);
                        *(f32x4*)(Y + (size_t)r * 1024 + col0 + bj * 128 + n * 16) = v; }
                s += __shfl_xor(s, 16); s += __shfl_xor(s, 32);
                if (fq == 0) SS[r * 16 + u.pn * 4 + wc] = s; }
    }
};
struct EpiUp {
    static constexpr bool PERM = true, AFTER_DRAIN = false;
    unsigned char* ws;
    __device__ __forceinline__ void operator()(const f32x4 (&acc)[2][2][4][2], const pg8::Unit& u, int wr, int wc, int fr, int fq) const {
        bf16_t* U = (bf16_t*)(ws + WS_U);
        const int row0 = u.pm * 256 + wr * 64 + fr, col0 = u.pn * 256 + wc * 32 + 8 * fq;
#pragma unroll
        for (int ai = 0; ai < 2; ++ai)
#pragma unroll
            for (int m = 0; m < 4; ++m) { bf16_t* rowp = U + (size_t)(row0 + ai * 128 + m * 16) * FF + col0;
#pragma unroll
                for (int bj = 0; bj < 2; ++bj) { f32x4 v0 = acc[ai][bj][m][0], v1 = acc[ai][bj][m][1];
#pragma unroll
                    for (int e = 0; e < 4; ++e) { const float a = fmaxf(v0[e], 0.f), b = fmaxf(v1[e], 0.f); v0[e] = a * a; v1[e] = b * b; }
                    *(u32x4*)(rowp + bj * 128) = pack8(v0, v1); } }
    }
};
struct MergeOrder {
    int G, c;
    __device__ bool next(int i, pg8::Unit& u) const { const int tile = c + G * (i / 3), b = i % 3; if (tile >= 256) return false; u.pm = b * 64 + (tile >> 2); u.pn = b * 4 + (tile & 3); return true; }
    __device__ __forceinline__ void a_ready(const pg8::Unit&) const {}
    __device__ __forceinline__ void done(const pg8::Unit&) const {}
};

struct AUnit {
    const bf16_t* q; long qs; const bf16_t* k; long ks; const bf16_t* k2; long k2s; const bf16_t* v; long vs;
    bf16_t* o; long os; float* lse; long lses;
    const int* posq; const int* posk; const int* tmm;
    int t0, t1, tq0, dil, bcol;
};
__device__ __forceinline__ int t5_bucket(int rel) {
    const int n = rel < 0 ? -rel : rel;
    const int b = n < 8 ? n : n < 12 ? 8 : n < 16 ? 9 : n < 23 ? 10 : n < 32 ? 11 : n < 46 ? 12 : n < 64 ? 13 : n < 91 ? 14 : 15;
    return b + (rel > 0 ? 16 : 0);
}
__device__ __forceinline__ int crow(int r, int hi) { return (r & 3) + 8 * (r >> 2) + 4 * hi; }
__device__ __forceinline__ int clamp128(int v) { return (v < -128 ? -128 : (v > 128 ? 128 : v)) + 128; }
typedef short v4i16_t __attribute__((ext_vector_type(4)));
__device__ __forceinline__ s16x4 vtr(const LAS unsigned char* p) { return __builtin_bit_cast(s16x4, __builtin_amdgcn_ds_read_tr16_b64_v4i16((LAS v4i16_t*)p)); }
__device__ __forceinline__ float max3f(float a, float b, float c) { float r; asm("v_max3_f32 %0, %1, %2, %3" : "=v"(r) : "v"(a), "v"(b), "v"(c)); return r; }
__device__ __forceinline__ float xhalf_max(float m) { auto rr = __builtin_amdgcn_permlane32_swap(__float_as_uint(m), __float_as_uint(m), false, false); return fmaxf(__uint_as_float(rr[0]), __uint_as_float(rr[1])); }
__device__ __forceinline__ float xhalf_sum(float m) { auto rr = __builtin_amdgcn_permlane32_swap(__float_as_uint(m), __float_as_uint(m), false, false); return __uint_as_float(rr[0]) + __uint_as_float(rr[1]); }

template <int MODE>
__device__ __forceinline__ void attn_unit(LAS unsigned char* lds, const AUnit& U, const float* __restrict__ rel_bias) {
    constexpr int DQK = MODE == 0 ? 96 : 64, DV = MODE == 0 ? 64 : 128;
    constexpr int KP = DQK * 2 + 16, VP = MODE == 0 ? 192 : 320;
    constexpr int KCPR = DQK / 8, VCPR = DV / 8, NKC = 64 * KCPR, NVC = 64 * VCPR, NS = DQK / 16, NB = DV / 32;
    constexpr int KBUF = 64 * 208, VBUF = 64 * 320, K_OFF = 0, V_OFF = 2 * KBUF, BT_OFF = V_OFF + 2 * VBUF;
    int tid = threadIdx.x; asm volatile("" : "+v"(tid));
    const int lane = tid & 63, wid = __builtin_amdgcn_readfirstlane(tid >> 6), q = lane & 31, hi = lane >> 5;
    LAS float* btab = (LAS float*)(lds + BT_OFF);
    if (MODE != 0) { for (int i = tid; i < 257; i += 512) btab[i] = LOG2E * rel_bias[t5_bucket(i - 128) * 20 + U.bcol]; }
    const bf16_t* src[3]; int dst[3];
    { const int row = tid >> 3, cc = tid & 7;
      src[0] = U.k + (long)row * U.ks + cc * 8 + (long)U.t0 * 64 * U.ks; dst[0] = K_OFF + row * KP + cc * 16;
      if (MODE == 0) {
          src[1] = U.v + (long)row * U.vs + cc * 8 + (long)U.t0 * 64 * U.vs; dst[1] = V_OFF + row * VP + cc * 16;
          const int r2 = (tid & 255) >> 2, c2 = tid & 3;
          src[2] = U.k2 + (long)r2 * U.k2s + c2 * 8 + (long)U.t0 * 64 * U.k2s; dst[2] = K_OFF + r2 * KP + 128 + c2 * 16;
      } else {
#pragma unroll
          for (int s = 1; s < 3; ++s) { const int c2 = tid + 512 * (s - 1), r2 = c2 >> 4, c3 = c2 & 15;
              src[s] = U.v + (long)r2 * U.vs + c3 * 8 + (long)U.t0 * 64 * U.vs; dst[s] = V_OFF + r2 * VP + c3 * 16; }
      } }
    const long step0 = 64 * U.ks, step1 = MODE == 0 ? 64 * U.vs : 64 * U.vs, step2 = MODE == 0 ? 64 * U.k2s : 64 * U.vs;
    const bool s2ok = MODE != 0 || tid < 256;
    const bf16_t* qrow = U.q + (long)(wid * 32 + q) * U.qs;
    bf16x8 qf[NS];
#pragma unroll
    for (int s = 0; s < NS; ++s) qf[s] = *(const bf16x8*)(qrow + 16 * s + 8 * hi);
    int pq = 0, qmin = 0, qmax = 0;
    if (MODE == 1) { pq = U.posq[wid * 32 + q]; qmin = pq; qmax = pq;
#pragma unroll
        for (int o = 1; o < 32; o <<= 1) { qmin = min(qmin, __shfl_xor(qmin, o)); qmax = max(qmax, __shfl_xor(qmax, o)); } }
    const int tq = U.tq0 + wid * 32 + q;
    const int wt0 = (U.tq0 >> 6) + (wid >> 1) - 1, wt1 = wt0 + 2;
    constexpr float THR = 8.f;
    float m_ref = 0.f, l_run = 0.f; bool first = true;
    f32x16 negm;
#pragma unroll
    for (int r = 0; r < 16; ++r) negm[r] = 0.f;
    f32x16 O[NB];
#pragma unroll
    for (int b = 0; b < NB; ++b)
#pragma unroll
        for (int r = 0; r < 16; ++r) O[b][r] = 0.f;
    u32x4 st[3];
    st[0] = *(const u32x4*)src[0]; st[1] = *(const u32x4*)src[1]; st[2] = *(const u32x4*)src[2]; src[0] += step0; src[1] += step1; src[2] += step2;
    *(LAS u32x4*)(lds + dst[0]) = st[0]; *(LAS u32x4*)(lds + dst[1]) = st[1]; if (s2ok) *(LAS u32x4*)(lds + dst[2]) = st[2];
    __syncthreads();
    for (int t = U.t0; t < U.t1; ++t) {
        const int buf = (t - U.t0) & 1;
        const bool more = t + 1 < U.t1;
        if (more) { st[0] = *(const u32x4*)src[0]; st[1] = *(const u32x4*)src[1]; st[2] = *(const u32x4*)src[2]; src[0] += step0; src[1] += step1; src[2] += step2; }
        if (MODE != 2 || (t >= wt0 && t <= wt1)) {
            const LAS unsigned char* kb = lds + K_OFF + buf * KBUF + q * KP + hi * 16;
            f32x16 p0, p1;
            { bf16x8 ka[NS], kc[NS];
#pragma unroll
              for (int s = 0; s < NS; ++s) { ka[s] = *(const LAS bf16x8*)(kb + s * 32); kc[s] = *(const LAS bf16x8*)(kb + 32 * KP + s * 32); }
              p0 = __builtin_amdgcn_mfma_f32_32x32x16_bf16(ka[0], qf[0], negm, 0, 0, 0);
              p1 = __builtin_amdgcn_mfma_f32_32x32x16_bf16(kc[0], qf[0], negm, 0, 0, 0);
#pragma unroll
              for (int s = 1; s < NS; ++s) {
                p0 = __builtin_amdgcn_mfma_f32_32x32x16_bf16(ka[s], qf[s], p0, 0, 0, 0);
                p1 = __builtin_amdgcn_mfma_f32_32x32x16_bf16(kc[s], qf[s], p1, 0, 0, 0); } }
            if (MODE == 0) asm volatile("s_nop 15\n\ts_nop 7" : "+v"(p0), "+v"(p1));
            const LAS unsigned char* vb = lds + V_OFF + buf * VBUF + (4 * hi + ((lane & 15) >> 2)) * VP + ((lane >> 4) & 1) * 32 + (lane & 3) * 8;
            s16x4 vlo[NB], vhi[NB];
#pragma unroll
            for (int b = 0; b < NB; ++b) { vlo[b] = vtr(vb + b * 64); vhi[b] = vtr(vb + 8 * VP + b * 64); }
            if (MODE == 1) {
                const int kmin = __builtin_amdgcn_readfirstlane(U.tmm[2 * t]), kmax = __builtin_amdgcn_readfirstlane(U.tmm[2 * t + 1]);
                if (kmin - qmax >= 128) { const float c = btab[256];
#pragma unroll
                    for (int r = 0; r < 16; ++r) { p0[r] += c; p1[r] += c; } }
                else if (kmax - qmin <= -128) { const float c = btab[0];
#pragma unroll
                    for (int r = 0; r < 16; ++r) { p0[r] += c; p1[r] += c; } }
                else { const int pk = U.posk[64 * t + lane];
#pragma unroll
                    for (int r = 0; r < 16; ++r) { const int kv = crow(r, hi); const int a = __shfl(pk, kv), b = __shfl(pk, kv + 32);
                        p0[r] += btab[clamp128(a - pq)]; p1[r] += btab[clamp128(b - pq)]; } }
            }
            if (MODE == 2) {
#pragma unroll
                for (int r = 0; r < 16; ++r) { const int rel0 = 64 * t + crow(r, hi) - tq, rel1 = rel0 + 32;
                    const float b0 = btab[clamp128(rel0 * U.dil)], b1 = btab[clamp128(rel1 * U.dil)];
                    p0[r] = (rel0 >= -64 && rel0 <= 64) ? p0[r] + b0 : -INFINITY;
                    p1[r] = (rel1 >= -64 && rel1 <= 64) ? p1[r] + b1 : -INFINITY; }
            }
            float mx;
            { float a = max3f(p0[0], p0[1], p1[0]), b = max3f(p0[2], p0[3], p1[1]); a = max3f(a, p1[2], p1[3]);
#pragma unroll
              for (int r = 4; r < 16; r += 4) { a = max3f(a, p0[r], p0[r + 1]); b = max3f(b, p0[r + 2], p0[r + 3]); a = max3f(a, p1[r], p1[r + 1]); b = max3f(b, p1[r + 2], p1[r + 3]); }
              mx = xhalf_max(fmaxf(a, b)); }
            if (first || __any(mx > THR)) {
                float dl = first ? (mx > -1e30f ? mx : 0.f) : fmaxf(mx, 0.f);
                first = false;
                m_ref += dl;
#pragma unroll
                for (int r = 0; r < 16; ++r) { p0[r] -= dl; p1[r] -= dl; negm[r] = -m_ref; }
                const float f = __builtin_amdgcn_exp2f(-dl);
                l_run *= f;
#pragma unroll
                for (int b = 0; b < NB; ++b)
#pragma unroll
                    for (int r = 0; r < 16; ++r) O[b][r] *= f;
            }
            float ls0 = 0.f, ls1 = 0.f;
#pragma unroll
            for (int r = 0; r < 16; ++r) { p0[r] = __builtin_amdgcn_exp2f(p0[r]); p1[r] = __builtin_amdgcn_exp2f(p1[r]); }
#pragma unroll
            for (int r = 0; r < 16; r += 4) { ls0 += p0[r]; ls1 += p1[r]; ls0 += p0[r + 1]; ls1 += p1[r + 1]; ls0 += p0[r + 2]; ls1 += p1[r + 2]; ls0 += p0[r + 3]; ls1 += p1[r + 3]; asm volatile("" : "+v"(ls0), "+v"(ls1)); }
            l_run += ls0 + ls1;
            bf16x8 pw[4];
            { u32x4 w;
              w.x = pk2(p0[0], p0[1]); w.y = pk2(p0[2], p0[3]); w.z = pk2(p0[4], p0[5]); w.w = pk2(p0[6], p0[7]); pw[0] = __builtin_bit_cast(bf16x8, w);
              w.x = pk2(p0[8], p0[9]); w.y = pk2(p0[10], p0[11]); w.z = pk2(p0[12], p0[13]); w.w = pk2(p0[14], p0[15]); pw[1] = __builtin_bit_cast(bf16x8, w);
              w.x = pk2(p1[0], p1[1]); w.y = pk2(p1[2], p1[3]); w.z = pk2(p1[4], p1[5]); w.w = pk2(p1[6], p1[7]); pw[2] = __builtin_bit_cast(bf16x8, w);
              w.x = pk2(p1[8], p1[9]); w.y = pk2(p1[10], p1[11]); w.z = pk2(p1[12], p1[13]); w.w = pk2(p1[14], p1[15]); pw[3] = __builtin_bit_cast(bf16x8, w); }
#pragma unroll
            for (int ks = 0; ks < 4; ++ks) {
                s16x4 nlo[NB], nhi[NB];
                if (ks < 3) {
#pragma unroll
                    for (int b = 0; b < NB; ++b) { nlo[b] = vtr(vb + (ks + 1) * 16 * VP + b * 64); nhi[b] = vtr(vb + ((ks + 1) * 16 + 8) * VP + b * 64); } }
#pragma unroll
                for (int b = 0; b < NB; ++b) { const bf16x8 vf = {vlo[b][0], vlo[b][1], vlo[b][2], vlo[b][3], vhi[b][0], vhi[b][1], vhi[b][2], vhi[b][3]};
                    O[b] = __builtin_amdgcn_mfma_f32_32x32x16_bf16(vf, pw[ks], O[b], 0, 0, 0); }
                if (ks < 3) {
#pragma unroll
                    for (int b = 0; b < NB; ++b) { vlo[b] = nlo[b]; vhi[b] = nhi[b]; } }
            }
        }
        if (more) { const int kb1 = (buf ^ 1) * KBUF, vb1 = (buf ^ 1) * VBUF;
            *(LAS u32x4*)(lds + dst[0] + kb1) = st[0]; *(LAS u32x4*)(lds + dst[1] + vb1) = st[1];
            if (s2ok) *(LAS u32x4*)(lds + dst[2] + (MODE == 0 ? kb1 : vb1)) = st[2]; }
        __syncthreads();
    }
    const float m_run = m_ref;
    const float l_tot = xhalf_sum(l_run), inv = 1.f / l_tot;
    bf16_t* orow = U.o + (long)(wid * 32 + q) * U.os;
#pragma unroll
    for (int b = 0; b < NB; ++b)
#pragma unroll
        for (int g4 = 0; g4 < 4; ++g4) { u32x2 w; w.x = pk2(O[b][4 * g4] * inv, O[b][4 * g4 + 1] * inv); w.y = pk2(O[b][4 * g4 + 2] * inv, O[b][4 * g4 + 3] * inv);
            *(u32x2*)(orow + 32 * b + 8 * g4 + 4 * hi) = w; }
    if (MODE == 2) { if (hi == 0) U.lse[(long)(wid * 32 + q) * U.lses] = m_run + log2f(l_tot); }
}

struct Params { const float* in[21]; float* out; unsigned char* ws; double inv[16]; float lam_init[4]; int ph_lo, ph_hi; };
enum { I_X = 0, I_POS, I_RELB, I_GMIXPRE, I_WIN, I_GQ, I_WUQ, I_GKV, I_WUKV, I_LQ1, I_LK1, I_LQ2, I_LK2, I_GDIFF, I_WBR, I_WOUT, I_GMIXPOST, I_GMLPPRE, I_WUP, I_WDN, I_GMLPPOST };
constexpr int LDS_BYTES = 147456;

__device__ __forceinline__ void transpose_item(const float* __restrict__ W, int ldw, int srccol0, bool inter, const float* __restrict__ kscale, bf16_t* WT, int K, int drow0, int k0, LAS float* scr, int lane) {
    const int c = lane & 31, sc = inter ? ((c & 1) * 16 + (c >> 1)) : c;
#pragma unroll 8
    for (int i = 0; i < 32; ++i) { const int kk = 2 * i + (lane >> 5); float v = 0.f;
        if (srccol0 >= 0) { v = W[(size_t)(k0 + kk) * ldw + srccol0 + sc]; if (kscale) v *= kscale[k0 + kk]; }
        scr[kk * 33 + c] = v; }
    asm volatile("s_waitcnt lgkmcnt(0)" ::: "memory");
    const int ch = lane & 7;
#pragma unroll
    for (int j = 0; j < 4; ++j) { const int n = (lane >> 3) + 8 * j; const LAS float* s = scr + (8 * ch) * 33 + n;
        u32x4 o; o.x = pk2(s[0 * 33], s[1 * 33]); o.y = pk2(s[2 * 33], s[3 * 33]); o.z = pk2(s[4 * 33], s[5 * 33]); o.w = pk2(s[6 * 33], s[7 * 33]);
        *(u32x4*)(WT + (size_t)(drow0 + n) * K + k0 + 8 * ch) = o; }
    asm volatile("s_waitcnt lgkmcnt(0)" ::: "memory");
}
__device__ __forceinline__ void convert_layer(const Params& p, int l, LAS unsigned char* lds, int gw, int NGW, int wave, int lane) {
    LAS float* scr = (LAS float*)(lds + wave * 16384);
    unsigned char* ws = p.ws;
    constexpr int I_IN = 16 * 224, I_UQ = 4 * 24, I_UKV = 2 * 32, I_BR = 3 * 8 * 32, I_OUT = 16 * 32, I_UP = 16 * 128, I_DN = 64 * 32;
    constexpr int NIT = I_IN + I_UQ + I_UKV + I_BR + I_OUT + I_UP + I_DN;
    for (int it = gw; it < NIT; it += NGW) {
        int r = it;
        if (r < I_IN) { const int kb = r / 224, nb = r % 224, n = nb * 32; int sc; bool inter = false;
            if (n < 3072) sc = 4000 + n; else if (n < 3328) sc = n - 3072; else if (n < 3456) sc = 256 + (n - 3328); else if (n < 3488) { sc = 384; inter = true; } else if (n < 3584) sc = -1; else sc = n - 3168;
            transpose_item(p.in[I_WIN] + (size_t)l * DM * INC, INC, sc, inter, nullptr, (bf16_t*)(ws + WS_WIN), DM, n, kb * 64, scr, lane); continue; }
        r -= I_IN;
        if (r < I_UQ) { const int kb = r / 24, nb = r % 24;
            transpose_item(p.in[I_WUQ] + (size_t)l * 256 * 768, 768, nb * 32, (nb % 3) == 2, p.in[I_GQ] + l * 256, (bf16_t*)(ws + WS_WUQ), 256, nb * 32, kb * 64, scr, lane); continue; }
        r -= I_UQ;
        if (r < I_UKV) { const int kb = r / 32, nb = r % 32;
            transpose_item(p.in[I_WUKV] + (size_t)l * 128 * 1024, 1024, nb * 32, false, p.in[I_GKV] + l * 128, (bf16_t*)(ws + WS_WUKV), 128, nb * 32, kb * 64, scr, lane); continue; }
        r -= I_UKV;
        if (r < I_BR) { const int b = r / 256, r2 = r % 256, kb = r2 / 32, nb = r2 % 32;
            transpose_item(p.in[I_WBR] + ((size_t)l * 3 + b) * 512 * 1024, 1024, nb * 32, false, nullptr, (bf16_t*)(ws + WS_WBR), 512, b * 1024 + nb * 32, kb * 64, scr, lane); continue; }
        r -= I_BR;
        if (r < I_OUT) { const int kb = r / 32, nb = r % 32;
            transpose_item(p.in[I_WOUT] + (size_t)l * DM * DM, DM, nb * 32, false, nullptr, (bf16_t*)(ws + WS_WOUT), DM, nb * 32, kb * 64, scr, lane); continue; }
        r -= I_OUT;
        if (r < I_UP) { const int kb = r / 128, nb = r % 128;
            transpose_item(p.in[I_WUP] + (size_t)l * DM * FF, FF, nb * 32, false, nullptr, (bf16_t*)(ws + WS_WUP), DM, nb * 32, kb * 64, scr, lane); continue; }
        r -= I_UP;
        { const int kb = r / 32, nb = r % 32;
            transpose_item(p.in[I_WDN] + (size_t)l * FF * DM, DM, nb * 32, false, nullptr, (bf16_t*)(ws + WS_WDN), FF, nb * 32, kb * 64, scr, lane); }
    }
}
__device__ __forceinline__ void norm_row(const float* xsrc, float* xdst, const float* y, const float* ssy, const float* gpost, const float* gpre, bf16_t* xn, int lane) {
    f32x4 v[4];
#pragma unroll
    for (int j = 0; j < 4; ++j) v[j] = *(const f32x4*)(xsrc + 4 * lane + 256 * j);
    if (y) {
        float s = 0.f;
#pragma unroll
        for (int k = 0; k < 16; ++k) s += ssy[k];
        const float rs = 1.f / sqrtf(s * (1.f / 1024.f) + EPS);
#pragma unroll
        for (int j = 0; j < 4; ++j) { const f32x4 yy = *(const f32x4*)(y + 4 * lane + 256 * j), g = *(const f32x4*)(gpost + 4 * lane + 256 * j);
            v[j] += yy * rs * g; *(f32x4*)(xdst + 4 * lane + 256 * j) = v[j]; }
    }
    if (xn) {
        float s2 = 0.f;
#pragma unroll
        for (int j = 0; j < 4; ++j) s2 += (v[j][0] * v[j][0] + v[j][1] * v[j][1]) + (v[j][2] * v[j][2] + v[j][3] * v[j][3]);
        const float rs = 1.f / sqrtf(wave_sum(s2) * (1.f / 1024.f) + EPS);
#pragma unroll
        for (int j = 0; j < 4; ++j) { const f32x4 g = *(const f32x4*)(gpre + 4 * lane + 256 * j); const f32x4 o = v[j] * rs * g;
            u32x2 w; w.x = pk2(o[0], o[1]); w.y = pk2(o[2], o[3]); *(u32x2*)(xn + 4 * lane + 256 * j) = w; }
    }
}


typedef unsigned v4u __attribute__((ext_vector_type(4)));
#define XB_TMO      128
#define XB_XCNT(j)  (256  + 64 * (j))
#define XB_XSUB(j)  (1280 + 64 * (j))
#define XB_XGEN(j)  (2304 + 64 * (j))
#define XB_TOP      3328
#define XB_TOPGEN   3392
#define XCD_BAR_WORDS 3456
#define XB_SPIN_CAP (1u << 18)

__device__ __forceinline__ unsigned xb_ld(unsigned* p)              { return __hip_atomic_load(p, __ATOMIC_RELAXED, __HIP_MEMORY_SCOPE_AGENT); }
__device__ __forceinline__ unsigned xb_add(unsigned* p, unsigned v) { return __hip_atomic_fetch_add(p, v, __ATOMIC_RELAXED, __HIP_MEMORY_SCOPE_AGENT); }
__device__ __forceinline__ unsigned xb_xcc_id() { return (unsigned)__builtin_amdgcn_s_getreg((3 << 11) | 20) & 0xFu; }
#define XB_SPIN(cond, bar) do { unsigned _sp = 0; while (cond) { __builtin_amdgcn_s_sleep(1); \
    if ((++_sp & 255u) == 0u) { if (xb_ld(&(bar)[XB_TMO])) break; if (_sp > XB_SPIN_CAP) { atomicAdd(&(bar)[XB_TMO], 1u); break; } } } } while (0)

struct XcdBarrier {
    unsigned* bar; unsigned x;
    volatile LAS unsigned* st;
};

__device__ __forceinline__ XcdBarrier xcd_barrier_post(unsigned* bar, volatile LAS unsigned* st) {
    XcdBarrier b; b.bar = bar; b.x = xb_xcc_id(); b.st = st;
    if (threadIdx.x == 0) (void)xb_add(&bar[XB_XCNT(b.x)], 1u);
    return b;
}
__device__ __forceinline__ void xcd_barrier_complete(unsigned* bar, unsigned x, unsigned& nloc, unsigned& nx) {
    const unsigned G = gridDim.x * gridDim.y * gridDim.z;
    unsigned sum, cnt, mine, sp = 0u;
    for (;;) {
        sum = 0u; cnt = 0u; mine = 0u;
#pragma unroll
        for (unsigned j = 0; j < 16; ++j) { const unsigned c = xb_ld(&bar[XB_XCNT(j)]); sum += c; cnt += (c > 0u) ? 1u : 0u; mine = (j == x) ? c : mine; }
        if (sum == G) break;
        __builtin_amdgcn_s_sleep(1);
        if ((++sp & 255u) == 0u) { if (xb_ld(&bar[XB_TMO])) break; if (sp > XB_SPIN_CAP) { atomicAdd(&bar[XB_TMO], 1u); break; } }
    }
    nloc = mine > 0u ? mine : 1u; nx = cnt > 0u ? cnt : 1u;
}

__device__ __forceinline__ void xcd_barrier(const XcdBarrier& b) {
    asm volatile("s_waitcnt vmcnt(0)" ::: "memory");
    __syncthreads();
    if (threadIdx.x == 0) {
        unsigned* bar = b.bar;
        __builtin_amdgcn_s_waitcnt(0);
        unsigned nloc = b.st[0], nx = b.st[1];
        if (nloc == 0u) { xcd_barrier_complete(bar, b.x, nloc, nx); b.st[0] = nloc; b.st[1] = nx; }
        const unsigned old = xb_add(&bar[XB_XSUB(b.x)], 1u);
        const unsigned gen = old / nloc;
        if (old + 1u == (gen + 1u) * nloc) {
            __builtin_amdgcn_fence(__ATOMIC_RELEASE, "agent");
            asm volatile("s_waitcnt vmcnt(0)" ::: "memory");
            const unsigned og = xb_add(&bar[XB_TOP], 1u);
            const unsigned tg = og / nx;
            if (og + 1u == (tg + 1u) * nx) xb_add(&bar[XB_TOPGEN], 1u);
            else XB_SPIN(xb_ld(&bar[XB_TOPGEN]) == tg, bar);
            __builtin_amdgcn_fence(__ATOMIC_ACQUIRE, "agent");
            xb_add(&bar[XB_XGEN(b.x)], 1u);
            asm volatile("s_waitcnt vmcnt(0)" ::: "memory");
        } else {
            XB_SPIN(xb_ld(&bar[XB_XGEN(b.x)]) == gen, bar);
            __builtin_amdgcn_fence(__ATOMIC_ACQUIRE, "agent");
            asm volatile("s_waitcnt vmcnt(0)" ::: "memory");
        }
    }
    __syncthreads();
}

__global__ void __launch_bounds__(512, 2) fwd_megakernel(Params p) {
    extern __shared__ __attribute__((aligned(16))) unsigned char lds_raw[];
    LAS unsigned char* lds = (LAS unsigned char*)lds_raw;
    cg::grid_group grid = cg::this_grid();
    volatile LAS unsigned* xst = (volatile LAS unsigned*)(lds + 131072 + 64);
    if (threadIdx.x < 2) xst[threadIdx.x] = 0u;
    __syncthreads();
    XcdBarrier xbar; xbar.bar = (unsigned*)p.ws; xbar.x = 0; xbar.st = xst;
    for (int ph = p.ph_lo; ph < p.ph_hi; ++ph) {
    int tid = threadIdx.x; asm volatile("" : "+v"(tid) :: "memory");
    const int lane = tid & 63, wave = __builtin_amdgcn_readfirstlane(tid >> 6);
    const int G = gridDim.x, gw = blockIdx.x * 8 + wave, NGW = G * 8;
    unsigned char* ws = p.ws;
    const int* pos = (const int*)p.in[I_POS];

    if (ph == 0) {
        if (blockIdx.x == 0) for (int i = tid; i < 4096; i += 512) __hip_atomic_store((unsigned*)p.ws + i, 0u, __ATOMIC_RELAXED, __HIP_MEMORY_SCOPE_AGENT);
        convert_layer(p, 0, lds, gw, NGW, wave, lane);
        float* rope = (float*)(ws + WS_ROPE);
        for (int i = blockIdx.x * 512 + tid; i < MALL * 16; i += G * 512) { const int tok = i >> 4, f = i & 15;
            const double rev = (double)pos[tok] * p.inv[f] * 0.15915494309189535; const float fr = (float)(rev - floor(rev));
            rope[tok * 32 + f] = __builtin_amdgcn_cosf(fr); rope[tok * 32 + 16 + f] = __builtin_amdgcn_sinf(fr); }
        int* tmm = (int*)(ws + WS_TMM);
        for (int i = gw; i < BATCH * 64; i += NGW) { int v = pos[i * 64 + lane], mn = v, mx = v;
#pragma unroll
            for (int o = 1; o < 64; o <<= 1) { mn = min(mn, __shfl_xor(mn, o)); mx = max(mx, __shfl_xor(mx, o)); }
            if (lane == 0) { tmm[2 * i] = mn; tmm[2 * i + 1] = mx; } }
        for (int r = gw; r < MALL; r += NGW)
            norm_row(p.in[I_X] + (size_t)r * DM, nullptr, nullptr, nullptr, nullptr, p.in[I_GMIXPRE], (bf16_t*)(ws + WS_XN) + (size_t)r * DM, lane);
    } else {
            const int pq_ = ph - 1, l = pq_ / 20, c = (pq_ / 10) & 1, kind = pq_ % 10;
            bf16_t* XN = (bf16_t*)(ws + WS_XN) + (size_t)c * MC * DM;
            const int tok0 = c * MC;
            const float* rope = (const float*)(ws + WS_ROPE);
            if (kind == 0) {
                pg8::Gemm g{XN, (const bf16_t*)(ws + WS_WIN), MC, NZ, DM, DM, DM}; pg8::StaticOrder S; S.init(MC, NZ, G, (int)blockIdx.x);
                EpiZ E{ws, rope, tok0};
                pg8::gemm_phase<EpiZ, pg8::StaticOrder, true, true>(lds, g, S, E);
            }
            else if (kind == 1) {
                { pg8::Gemm g{(const bf16_t*)(ws + WS_CQ), (const bf16_t*)(ws + WS_WUQ), MC, 768, 256, 256, 256}; pg8::StaticOrder S; S.init(MC, 768, G, (int)blockIdx.x);
                  EpiUpQ E{ws, rope, tok0}; pg8::gemm_phase<EpiUpQ, pg8::StaticOrder, true, true>(lds, g, S, E); }
                { pg8::Gemm g{(const bf16_t*)(ws + WS_CKV), (const bf16_t*)(ws + WS_WUKV), MC, 1024, 128, 128, 128}; pg8::StaticOrder S; S.init(MC, 1024, G, (int)blockIdx.x);
                  EpiUpKV E{ws}; pg8::gemm_phase<EpiUpKV, pg8::StaticOrder, true, true>(lds, g, S, E); }
            }
            else if (kind == 2) {
                const float* relb = p.in[I_RELB];
                for (int u = blockIdx.x; u < 1792; u += G) {
                    AUnit U{};
                    if (u < 512) {
                        const int qb = u & 15, h = (u >> 4) & 3, m = (u >> 6) & 1, b = u >> 7; const long row0 = (long)b * SEQ;
                        U.q = (const bf16_t*)(ws + WS_FQ) + (row0 + 256 * qb) * 512 + (m * 4 + h) * 64; U.qs = 512;
                        U.k = (const bf16_t*)(ws + WS_FK) + row0 * 512 + (m * 4 + h) * 64; U.ks = 512; U.k2 = U.k; U.k2s = 0;
                        U.v = (const bf16_t*)(ws + WS_FV) + row0 * 512 + h * 128; U.vs = 512;
                        U.o = XN + ((long)m * MC + row0 + 256 * qb) * 512 + h * 128; U.os = 512;
                        U.posq = pos + tok0 + row0 + 256 * qb; U.posk = pos + tok0 + row0; U.tmm = (const int*)(ws + WS_TMM) + (c * CB + b) * 128;
                        U.t0 = 0; U.t1 = 64; U.bcol = 12 + m * 4 + h;
                        attn_unit<1>(lds, U, relb);
                    } else if (u < 1024) {
                        const int v = u - 512, qb = v & 15, h = (v >> 4) & 7, b = v >> 7; const long row0 = (long)b * SEQ;
                        U.q = (const bf16_t*)(ws + WS_Q) + (row0 + 256 * qb) * 768 + h * 96; U.qs = 768;
                        U.k = (const bf16_t*)(ws + WS_KV) + row0 * 1024 + h * 128; U.ks = 1024;
                        U.k2 = (const bf16_t*)(ws + WS_KR) + row0 * 32; U.k2s = 32;
                        U.v = (const bf16_t*)(ws + WS_KV) + row0 * 1024 + h * 128 + 64; U.vs = 1024;
                        U.o = (bf16_t*)(ws + WS_OA) + (row0 + 256 * qb) * 512 + h * 64; U.os = 512;
                        U.t0 = 0; U.t1 = 64;
                        attn_unit<0>(lds, U, relb);
                    } else {
                        const int v = u - 1024, u16 = v & 15, g = (v >> 4) % 3, bh = (v >> 4) / 3, h = bh & 3, b = bh >> 2;
                        const int dil = g == 0 ? 1 : (g == 1 ? 4 : 16), L = SEQ / dil, nblk = L / 256, rr = u16 / nblk, nb = u16 % nblk;
                        const long base = (long)b * SEQ + rr, qrow0 = base + (long)256 * nb * dil;
                        U.q = (const bf16_t*)(ws + WS_DQ) + qrow0 * 768 + (g * 4 + h) * 64; U.qs = 768L * dil;
                        U.k = (const bf16_t*)(ws + WS_DK) + base * 768 + (g * 4 + h) * 64; U.ks = 768L * dil; U.k2 = U.k; U.k2s = 0;
                        U.v = (const bf16_t*)(ws + WS_DV) + base * 512 + h * 128; U.vs = 512L * dil;
                        U.o = (bf16_t*)(ws + WS_PB) + ((long)g * MC + qrow0) * 512 + h * 128; U.os = 512L * dil;
                        U.lse = (float*)(ws + WS_LSE) + ((long)g * MC + qrow0) * 4 + h; U.lses = 4L * dil;
                        U.t0 = max(0, 4 * nb - 1); U.t1 = min(L / 64, 4 * nb + 5); U.tq0 = 256 * nb; U.dil = dil; U.bcol = g * 4 + h;
                        attn_unit<2>(lds, U, relb);
                    }
                }
            }
            else if (kind == 3) {
                const float a1 = wave_sum(p.in[I_LQ1][l * 64 + lane] * p.in[I_LK1][l * 64 + lane]), a2 = wave_sum(p.in[I_LQ2][l * 64 + lane] * p.in[I_LK2][l * 64 + lane]);
                const float lam_init = p.lam_init[l], lam = expf(a1) - expf(a2) + lam_init, osc = 1.f - lam_init;
                const bf16_t* PB = (const bf16_t*)(ws + WS_PB); const float* LSE = (const float*)(ws + WS_LSE);
                bf16_t* OB = (bf16_t*)(ws + WS_OA) + (size_t)MC * 512; bf16_t* OC = OB + (size_t)MC * 512;
                const float* gs = p.in[I_GDIFF] + l * 128 + (lane & 15) * 8;
                const f32x4 gs0 = *(const f32x4*)gs, gs1 = *(const f32x4*)(gs + 4);
                for (int r = gw; r < MC; r += NGW) {
                    const int h = lane >> 4;
                    const float l0 = LSE[(size_t)r * 4 + h], l1 = LSE[((size_t)MC + r) * 4 + h], l2 = LSE[((size_t)2 * MC + r) * 4 + h];
                    const float mx = fmaxf(l0, fmaxf(l1, l2));
                    float w0 = __builtin_amdgcn_exp2f(l0 - mx), w1 = __builtin_amdgcn_exp2f(l1 - mx), w2 = __builtin_amdgcn_exp2f(l2 - mx);
                    const float wi = 1.f / (w0 + w1 + w2); w0 *= wi; w1 *= wi; w2 *= wi;
                    const u32x4 x0 = *(const u32x4*)(PB + (size_t)r * 512 + lane * 8), x1 = *(const u32x4*)(PB + ((size_t)MC + r) * 512 + lane * 8), x2 = *(const u32x4*)(PB + ((size_t)2 * MC + r) * 512 + lane * 8);
                    u32x4 ob;
#pragma unroll
                    for (int e = 0; e < 4; ++e) ob[e] = pk2(w0 * bflo(x0[e]) + w1 * bflo(x1[e]) + w2 * bflo(x2[e]), w0 * bfhi(x0[e]) + w1 * bfhi(x1[e]) + w2 * bfhi(x2[e]));
                    *(u32x4*)(OB + (size_t)r * 512 + lane * 8) = ob;
                    const u32x4 c0 = *(const u32x4*)(XN + (size_t)r * 512 + lane * 8), c1 = *(const u32x4*)(XN + ((size_t)MC + r) * 512 + lane * 8);
                    float d[8]; float ss = 0.f;
#pragma unroll
                    for (int e = 0; e < 4; ++e) { d[2 * e] = bflo(c0[e]) - lam * bflo(c1[e]); d[2 * e + 1] = bfhi(c0[e]) - lam * bfhi(c1[e]); ss += d[2 * e] * d[2 * e] + d[2 * e + 1] * d[2 * e + 1]; }
                    ss += __shfl_xor(ss, 1); ss += __shfl_xor(ss, 2); ss += __shfl_xor(ss, 4); ss += __shfl_xor(ss, 8);
                    const float rs = osc / sqrtf(ss * (1.f / 128.f) + EPS);
                    u32x4 oc; oc.x = pk2(d[0] * rs * gs0[0], d[1] * rs * gs0[1]); oc.y = pk2(d[2] * rs * gs0[2], d[3] * rs * gs0[3]); oc.z = pk2(d[4] * rs * gs1[0], d[5] * rs * gs1[1]); oc.w = pk2(d[6] * rs * gs1[2], d[7] * rs * gs1[3]);
                    *(u32x4*)(OC + (size_t)r * 512 + lane * 8) = oc;
                }
            }
            else if (kind == 4) {
                pg8::Gemm g{(const bf16_t*)(ws + WS_OA), (const bf16_t*)(ws + WS_WBR), 3 * MC, 3 * DM, 512, 512, 512}; MergeOrder S{G, (int)blockIdx.x};
                EpiMerge E{ws, XN}; pg8::gemm_phase<EpiMerge, MergeOrder, true, true>(lds, g, S, E);
            }
            else if (kind == 5) {
                pg8::Gemm g{XN, (const bf16_t*)(ws + WS_WOUT), MC, DM, DM, DM, DM}; pg8::StaticOrder S; S.init(MC, DM, G, (int)blockIdx.x);
                EpiF32 E{ws}; pg8::gemm_phase<EpiF32, pg8::StaticOrder, true, true>(lds, g, S, E);
            }
            else if (kind == 6) {
                const float* xsrc = (l == 0 ? p.in[I_X] : p.out) + (size_t)tok0 * DM; float* xdst = p.out + (size_t)tok0 * DM;
                for (int r = gw; r < MC; r += NGW)
                    norm_row(xsrc + (size_t)r * DM, xdst + (size_t)r * DM, (const float*)(ws + WS_Y) + (size_t)r * DM, (const float*)(ws + WS_SSY) + r * 16, p.in[I_GMIXPOST] + l * DM, p.in[I_GMLPPRE] + l * DM, XN + (size_t)r * DM, lane);
            }
            else if (kind == 7) {
                pg8::Gemm g{XN, (const bf16_t*)(ws + WS_WUP), MC, FF, DM, DM, DM}; pg8::StaticOrder S; S.init(MC, FF, G, (int)blockIdx.x);
                EpiUp E{ws}; pg8::gemm_phase<EpiUp, pg8::StaticOrder, true, true>(lds, g, S, E);
            }
            else if (kind == 8) {
                pg8::Gemm g{(const bf16_t*)(ws + WS_U), (const bf16_t*)(ws + WS_WDN), MC, DM, FF, FF, FF}; pg8::StaticOrder S; S.init(MC, DM, G, (int)blockIdx.x);
                EpiF32 E{ws}; pg8::gemm_phase<EpiF32, pg8::StaticOrder, true, true>(lds, g, S, E);
            }
            else if (kind == 9) {
                float* xdst = p.out + (size_t)tok0 * DM; const bool lastl = l == DEPTH - 1;
                for (int r = gw; r < MC; r += NGW)
                    norm_row(xdst + (size_t)r * DM, xdst + (size_t)r * DM, (const float*)(ws + WS_Y) + (size_t)r * DM, (const float*)(ws + WS_SSY) + r * 16, p.in[I_GMLPPOST] + l * DM,
                             lastl ? nullptr : p.in[I_GMIXPRE] + (l + 1) * DM, lastl ? nullptr : XN + (size_t)r * DM, lane);
                if (c == NCHUNK - 1 && !lastl) { __syncthreads(); convert_layer(p, l + 1, lds, gw, NGW, wave, lane); }
            }
    }
    if (ph + 1 < p.ph_hi) {
        if (ph == 0) { grid.sync(); xbar = xcd_barrier_post((unsigned*)p.ws, xst); }
        else xcd_barrier(xbar);
    }
    }
}

constexpr int N_PHASES = 1 + DEPTH * NCHUNK * 10;
extern "C" void kernel_launch(void* const* d_in, const int* in_sizes, int n_in, void* d_out, int out_size, void* d_ws, size_t ws_size, hipStream_t stream) {
    static int grid = 0;
    if (grid == 0) {
        if (n_in != 21 || out_size != MALL * DM || ws_size < WS_END) { fprintf(stderr, "kernel_launch: unexpected shapes (n_in %d out %d ws %zu)\n", n_in, out_size, ws_size); grid = -1; return; }
        int dev = 0, cus = 0, per_cu = 0;
        (void)hipGetDevice(&dev); (void)hipDeviceGetAttribute(&cus, hipDeviceAttributeMultiprocessorCount, dev);
        (void)hipFuncSetAttribute((const void*)fwd_megakernel, hipFuncAttributeMaxDynamicSharedMemorySize, LDS_BYTES);
        (void)hipOccupancyMaxActiveBlocksPerMultiprocessor(&per_cu, (const void*)fwd_megakernel, 512, LDS_BYTES);
        if (per_cu < 1) per_cu = 1;
        grid = cus * per_cu;
    }
    if (grid < 0) return;
    Params p{};
    for (int i = 0; i < 21; ++i) p.in[i] = (const float*)d_in[i];
    p.out = (float*)d_out; p.ws = (unsigned char*)d_ws;
    for (int i = 0; i < 16; ++i) p.inv[i] = pow(10000.0, -(double)i / 16.0);
    for (int l = 0; l < 4; ++l) p.lam_init[l] = (float)(0.8 - 0.6 * exp(-0.3 * (double)l));
    p.ph_lo = 0; p.ph_hi = N_PHASES;
    void* args[] = {&p};
    hipError_t e = hipLaunchCooperativeKernel((const void*)fwd_megakernel, dim3(grid), dim3(512), args, LDS_BYTES, stream);
    if (e != hipSuccess) fprintf(stderr, "cooperative launch failed: %s (grid %d)\n", hipGetErrorString(e), grid);
}
```

```cpp
#include <hip/hip_runtime.h>
#include <hip/hip_cooperative_groups.h>
#include <cstdio>
#include <cstdint>
#include <cmath>
namespace cg = cooperative_groups;

#define LAS __attribute__((address_space(3)))
typedef float f32x2 __attribute__((ext_vector_type(2)));
typedef float f32x16 __attribute__((ext_vector_type(16)));
typedef unsigned u32x2 __attribute__((ext_vector_type(2)));
typedef short s16x4 __attribute__((ext_vector_type(4)));
typedef __bf16 bf16x2_t __attribute__((ext_vector_type(2)));
__device__ __forceinline__ unsigned pk2(float lo, float hi) { f32x2 v = {lo, hi}; bf16x2_t b = __builtin_convertvector(v, bf16x2_t); return __builtin_bit_cast(unsigned, b); }
__device__ __forceinline__ float bflo(unsigned w) { return __uint_as_float(w << 16); }
__device__ __forceinline__ float bfhi(unsigned w) { return __uint_as_float(w & 0xffff0000u); }
__device__ __forceinline__ float wave_sum(float v) {
#pragma unroll
    for (int o = 1; o < 64; o <<= 1) v += __shfl_xor(v, o);
    return v;
}

constexpr int DM = 1024, SEQ = 4096, BATCH = 8, DEPTH = 4, MALL = BATCH * SEQ, CB = 4, MC = CB * SEQ, NCHUNK = 2;
constexpr int NZ = 7168, FF = 4096, INC = 7072;
constexpr float EPS = 1e-6f, LOG2E = 1.4426950408889634f;
constexpr size_t MiB = 1u << 20;
constexpr size_t WS_SSQ = 1 * MiB, WS_SSKV = 1 * MiB + 512 * 1024, WS_SSY = 2 * MiB, WS_LSE = 3 * MiB, WS_TMM = 3 * MiB + 800 * 1024;
constexpr size_t WS_ROPE = 4 * MiB;
constexpr size_t WS_WIN = 8 * MiB, WS_WUQ = 22 * MiB, WS_WUKV = 22 * MiB + 512 * 1024, WS_WBR = 23 * MiB, WS_WOUT = 26 * MiB, WS_WUP = 28 * MiB, WS_WDN = 36 * MiB;
constexpr size_t WS_XN = 44 * MiB;
constexpr size_t WS_G = 108 * MiB;
constexpr size_t WS_CQ = 204 * MiB, WS_CKV = 212 * MiB, WS_KR = 216 * MiB;
constexpr size_t WS_DQ = 218 * MiB, WS_DK = 242 * MiB, WS_DV = 266 * MiB, WS_FQ = 282 * MiB, WS_FK = 298 * MiB, WS_FV = 314 * MiB;
constexpr size_t WS_Q = 330 * MiB, WS_KV = 354 * MiB;
constexpr size_t WS_OA = 386 * MiB;
constexpr size_t WS_PB = 434 * MiB;
constexpr size_t WS_END = 482 * MiB;
constexpr size_t WS_U = 108 * MiB;
constexpr size_t WS_Y = 236 * MiB;
namespace pg8 {
#define PG8_LAS __attribute__((address_space(3)))
typedef unsigned short bf16_t;
typedef short bf16x8 __attribute__((ext_vector_type(8)));
typedef float f32x4 __attribute__((ext_vector_type(4)));
typedef unsigned u32x4 __attribute__((ext_vector_type(4)));
constexpr int BM = 256, BK = 64, HALF = 128, HTB = HALF * BK * 2  , STAGE_BYTES = 8 * HTB, NXCD = 8, WGM = 8;

__host__ __device__ __forceinline__ int lds_byte(int r, int c) { const int st = (r >> 4) * 2 + (c >> 5), rr = r & 15, cc = c & 31, ob = rr * 64 + cc * 2; return st * 1024 + (ob ^ (((ob >> 9) & 1) << 5)); }
__host__ __device__ __forceinline__ void stage_rc(int b, int& R, int& C) { const int st = b / 1024, sb = b % 1024, swz = sb ^ (((sb >> 9) & 1) << 5); R = (st >> 1) * 16 + swz / 64; C = (st & 1) * 32 + (swz % 64) / 2; }
__host__ __device__ __forceinline__ int perm32(int rho) { const int n = rho >> 4, i = rho & 15; return 8 * (i >> 2) + 4 * n + (i & 3); }

struct Unit { int pm, pn; };
struct Gemm { const bf16_t* A; const bf16_t* Bt; int M, N, K, lda, ldb; };

struct StaticOrder {
    int nM, nN, nwg, G, c;
    __host__ __device__ void init(int M, int N, int G_, int c_) { nM = M / BM; nN = N / BM; nwg = nM * nN; G = G_; c = c_; }
    __host__ __device__ bool next(int i, Unit& u) const {
        const long L = (long)i * G + c; if (L >= nwg) return false;
        int wgid = (int)L; { const int q = nwg / NXCD, r = nwg % NXCD, xcd = wgid % NXCD, off = wgid / NXCD; wgid = (xcd < r ? xcd * (q + 1) : r * (q + 1) + (xcd - r) * q) + off; }
        const int nig = WGM * nN, gid = wgid / nig, fm = gid * WGM, gsz = (nM - fm) < WGM ? (nM - fm) : WGM;
        u.pm = fm + ((wgid % nig) % gsz); u.pn = (wgid % nig) / gsz; return true;
    }
    __device__ __forceinline__ void a_ready(const Unit&) const {}
    __device__ __forceinline__ void done(const Unit&) const {}
};


template <class Epi, class Sched, bool ALIGN_EPI = false, bool SP2 = false>
__device__ __forceinline__ void gemm_phase(PG8_LAS unsigned char* lds, const Gemm g, const Sched& S, const Epi& E) {
    int tid = threadIdx.x; asm volatile("" : "+v"(tid));
    const int wid = __builtin_amdgcn_readfirstlane(tid >> 6), lane = tid & 63, wr = wid >> 2, wc = wid & 3, fr = lane & 15, fq = lane >> 4;
    int K = g.K; asm volatile("" : "+s"(K)); const int nt = K / BK;
    unsigned voffA[2], voffB[2];
#pragma unroll
    for (int i = 0; i < 2; ++i) { int R, C; stage_rc(tid * 16 + i * 8192, R, C); const int Rb = Epi::PERM ? ((R & ~31) + perm32(R & 31)) : R;
        voffA[i] = (unsigned)(R * g.lda + C) * 2u; voffB[i] = (unsigned)(Rb * g.ldb + C) * 2u; }
    const size_t kstep = (size_t)(BK * 2);
    const size_t hstepA = (size_t)HALF * g.lda * 2, hstepB = (size_t)HALF * g.ldb * 2;
    const size_t tstepA = 2 * hstepA, tstepB = 2 * hstepB;
    const unsigned ldsw = (unsigned)wid * 1024u;
    const int aoff = lds_byte(wr * 64 + fr, fq * 8), boff = lds_byte(wc * 32 + fr, fq * 8);
#define PG8_SA(b, h) (((b) * 2 + (h)) * HTB)
#define PG8_SB(b, h) ((4 + (b) * 2 + (h)) * HTB)
#define PG8_STAGE(bufoff, gbase, voff) do { _Pragma("unroll") for (int _i = 0; _i < 2; ++_i) \
        __builtin_amdgcn_global_load_lds((const unsigned*)((const char*)(gbase) + (voff)[_i]), (PG8_LAS unsigned*)(lds + (bufoff) + ldsw + _i * 8192), 16, 0, 0); } while (0)
#define PG8_LDA(dst, b, h) do { _Pragma("unroll") for (int m = 0; m < 4; ++m) _Pragma("unroll") for (int k = 0; k < 2; ++k) dst[m][k] = *(const PG8_LAS bf16x8*)(lds + PG8_SA(b, h) + aoff + m * 2048 + k * 1024); } while (0)
#define PG8_LDB(dst, b, h) do { _Pragma("unroll") for (int n = 0; n < 2; ++n) _Pragma("unroll") for (int k = 0; k < 2; ++k) dst[n][k] = *(const PG8_LAS bf16x8*)(lds + PG8_SB(b, h) + boff + n * 2048 + k * 1024); } while (0)
#define PG8_MMA(ai, bj, At, Bt) do { __builtin_amdgcn_s_setprio(1); _Pragma("unroll") for (int m = 0; m < 4; ++m) _Pragma("unroll") for (int n = 0; n < 2; ++n) _Pragma("unroll") for (int k = 0; k < 2; ++k) \
        acc[ai][bj][m][n] = __builtin_amdgcn_mfma_f32_16x16x32_bf16(Bt[n][k], At[m][k], acc[ai][bj][m][n], 0, 0, 0); __builtin_amdgcn_s_setprio(0); } while (0)
#define PG8_WAIT_V(n) asm volatile("s_waitcnt vmcnt(" #n ")" ::: "memory")
#define PG8_WAIT_L(n) asm volatile("s_waitcnt lgkmcnt(" #n ")" ::: "memory")
#define PG8_BAR __builtin_amdgcn_s_barrier()
#define PG8_SCHED __builtin_amdgcn_sched_barrier(0)
    Unit cur, nxt; int ui = 0;
    if (!S.next(0, cur)) return;
    f32x4 acc[2][2][4][2];
#pragma unroll
    for (int a = 0; a < 2; ++a)
#pragma unroll
        for (int b = 0; b < 2; ++b)
#pragma unroll
            for (int m = 0; m < 4; ++m)
#pragma unroll
                for (int n = 0; n < 2; ++n) acc[a][b][m][n] = (f32x4){0.f, 0.f, 0.f, 0.f};
    bf16x8 At[4][2], B0[2][2], B1[2][2];
    const char* cA = (const char*)g.A + (size_t)cur.pm * tstepA; const char* cB = (const char*)g.Bt + (size_t)cur.pn * tstepB;
    S.a_ready(cur);
    if constexpr (SP2) {
        PG8_STAGE(PG8_SB(0, 0), cB, voffB); PG8_STAGE(PG8_SB(0, 1), cB + hstepB, voffB); PG8_STAGE(PG8_SA(0, 0), cA, voffA); PG8_STAGE(PG8_SA(0, 1), cA + hstepA, voffA);
        if (wr == 1) PG8_BAR;
        PG8_WAIT_V(2); PG8_BAR;
        PG8_STAGE(PG8_SB(1, 0), cB + kstep, voffB); PG8_STAGE(PG8_SA(1, 0), cA + kstep, voffA); PG8_STAGE(PG8_SB(1, 1), cB + hstepB + kstep, voffB);
        PG8_WAIT_V(6); PG8_BAR;
    } else {
        PG8_STAGE(PG8_SB(0, 0), cB, voffB); PG8_STAGE(PG8_SA(0, 0), cA, voffA); PG8_STAGE(PG8_SB(0, 1), cB + hstepB, voffB); PG8_STAGE(PG8_SA(0, 1), cA + hstepA, voffA);
        if (wr == 1) PG8_BAR;
        PG8_WAIT_V(4); PG8_BAR;
        PG8_STAGE(PG8_SB(1, 0), cB + kstep, voffB); PG8_STAGE(PG8_SA(1, 0), cA + kstep, voffA); PG8_STAGE(PG8_SB(1, 1), cB + hstepB + kstep, voffB);
        PG8_WAIT_V(6); PG8_BAR;
    }
    for (;;) {
        const bool has_next = S.next(ui + 1, nxt);
        const char* nA = has_next ? (const char*)g.A + (size_t)nxt.pm * tstepA : cA; const char* nB = has_next ? (const char*)g.Bt + (size_t)nxt.pn * tstepB : cB;
        for (int t = 0; t < nt; t += 2) {
            const bool last = (t == nt - 2);
            const char* a1 = cA + (size_t)(t + 1) * kstep;
            const char* a2 = last ? nA : cA + (size_t)(t + 2) * kstep; const char* b2 = last ? nB : cB + (size_t)(t + 2) * kstep;
            const char* a3 = a2 + kstep; const char* b3 = b2 + kstep;
            if (last && has_next) S.a_ready(nxt);
            if constexpr (Epi::HAS_MIDK) { if (t == 8 || t == 16) E.midk(acc, cur, t, wr, wc, fr, fq); }
            if constexpr (SP2) {
            PG8_LDB(B0, 0, 0); PG8_LDB(B1, 0, 1); PG8_SCHED; PG8_LDA(At, 0, 0); PG8_STAGE(PG8_SA(1, 1), a1 + hstepA, voffA);
            PG8_WAIT_V(8); PG8_WAIT_L(0); PG8_BAR; PG8_MMA(0, 0, At, B0); PG8_MMA(0, 1, At, B1); PG8_BAR; PG8_SCHED;
            PG8_LDA(At, 0, 1); PG8_STAGE(PG8_SB(0, 0), b2, voffB); PG8_STAGE(PG8_SB(0, 1), b2 + hstepB, voffB); PG8_STAGE(PG8_SA(0, 0), a2, voffA);
            PG8_WAIT_V(8); PG8_WAIT_L(0); PG8_BAR; PG8_MMA(1, 0, At, B0); PG8_MMA(1, 1, At, B1); PG8_BAR; PG8_SCHED;
            PG8_LDB(B0, 1, 0); PG8_LDB(B1, 1, 1); PG8_SCHED; PG8_LDA(At, 1, 0); PG8_STAGE(PG8_SA(0, 1), a2 + hstepA, voffA);
            PG8_WAIT_V(8); PG8_WAIT_L(0); PG8_BAR; PG8_MMA(0, 0, At, B0); PG8_MMA(0, 1, At, B1); PG8_BAR; PG8_SCHED;
            PG8_LDA(At, 1, 1); PG8_STAGE(PG8_SB(1, 0), b3, voffB); PG8_STAGE(PG8_SB(1, 1), b3 + hstepB, voffB); PG8_STAGE(PG8_SA(1, 0), a3, voffA);
            PG8_WAIT_V(8); PG8_WAIT_L(0); PG8_BAR; PG8_MMA(1, 0, At, B0); PG8_MMA(1, 1, At, B1); PG8_BAR; PG8_SCHED;
            } else {
            PG8_LDB(B0, 0, 0); PG8_SCHED; PG8_LDA(At, 0, 0); PG8_STAGE(PG8_SA(1, 1), a1 + hstepA, voffA);
            PG8_WAIT_L(8); PG8_BAR; PG8_WAIT_L(0); PG8_MMA(0, 0, At, B0); PG8_BAR; PG8_SCHED;
            PG8_LDB(B1, 0, 1); PG8_STAGE(PG8_SB(0, 0), b2, voffB);
            PG8_BAR; PG8_WAIT_L(0); PG8_MMA(0, 1, At, B1); PG8_BAR;
            PG8_LDA(At, 0, 1); PG8_STAGE(PG8_SA(0, 0), a2, voffA);
            PG8_BAR; PG8_WAIT_L(0); PG8_MMA(1, 0, At, B0); PG8_BAR; PG8_SCHED;
            PG8_STAGE(PG8_SB(0, 1), b2 + hstepB, voffB);
            PG8_WAIT_V(6); PG8_BAR; PG8_MMA(1, 1, At, B1); PG8_BAR;
            PG8_LDB(B0, 1, 0); PG8_SCHED; PG8_LDA(At, 1, 0); PG8_STAGE(PG8_SA(0, 1), a2 + hstepA, voffA);
            PG8_WAIT_L(8); PG8_BAR; PG8_WAIT_L(0); PG8_MMA(0, 0, At, B0); PG8_BAR; PG8_SCHED;
            PG8_LDB(B1, 1, 1); PG8_STAGE(PG8_SB(1, 0), b3, voffB);
            PG8_BAR; PG8_WAIT_L(0); PG8_MMA(0, 1, At, B1); PG8_BAR;
            PG8_LDA(At, 1, 1); PG8_STAGE(PG8_SA(1, 0), a3, voffA);
            PG8_BAR; PG8_WAIT_L(0); PG8_MMA(1, 0, At, B0); PG8_BAR; PG8_SCHED;
            PG8_STAGE(PG8_SB(1, 1), b3 + hstepB, voffB);
            PG8_WAIT_V(6); PG8_BAR; PG8_MMA(1, 1, At, B1); PG8_BAR;
            }
        }
        if constexpr (ALIGN_EPI) { if (wr == 0) PG8_BAR; }
        if constexpr (!Epi::AFTER_DRAIN) { E(acc, cur, wr, wc, fr, fq); S.done(cur); }
        if (!has_next) break;
#pragma unroll
        for (int a = 0; a < 2; ++a)
#pragma unroll
            for (int b = 0; b < 2; ++b)
#pragma unroll
                for (int m = 0; m < 4; ++m)
#pragma unroll
                    for (int n = 0; n < 2; ++n) acc[a][b][m][n] = (f32x4){0.f, 0.f, 0.f, 0.f};
        cur = nxt; cA = nA; cB = nB; ++ui;
        if constexpr (ALIGN_EPI) { if (wr == 1) PG8_BAR; }
    }
    PG8_WAIT_V(0);
    if constexpr (!ALIGN_EPI) { if (wr == 0) PG8_BAR; }
    PG8_BAR;
    if constexpr (Epi::AFTER_DRAIN) { E.fused(acc, cur, wr, wc, fr, fq, lds, wid, lane); S.done(cur); }
#undef PG8_SA
#undef PG8_SB
#undef PG8_STAGE
#undef PG8_LDA
#undef PG8_LDB
#undef PG8_MMA
#undef PG8_WAIT_V
#undef PG8_WAIT_L
#undef PG8_BAR
#undef PG8_SCHED
}
}

using pg8::bf16_t; using pg8::f32x4; using pg8::u32x4; using pg8::bf16x8;
constexpr float QSCALE_MLA = 0.10206207261596575f * LOG2E;
constexpr float QSCALE_64 = 0.125f * LOG2E;
__device__ __forceinline__ float sigmoidf_fast(float v) { return __builtin_amdgcn_rcpf(1.f + __builtin_amdgcn_exp2f(-v * LOG2E)); }
__device__ __forceinline__ u32x4 pack8(const f32x4 a, const f32x4 b) { u32x4 w; w.x = pk2(a[0], a[1]); w.y = pk2(a[2], a[3]); w.z = pk2(b[0], b[1]); w.w = pk2(b[2], b[3]); return w; }
__device__ __forceinline__ void rope8(f32x4& a, f32x4& b, const f32x4 c, const f32x4 s) {
    f32x4 ra, rb;
    ra[0] = a[0] * c[0] - a[1] * s[0]; ra[1] = a[1] * c[0] + a[0] * s[0];
    ra[2] = a[2] * c[1] - a[3] * s[1]; ra[3] = a[3] * c[1] + a[2] * s[1];
    rb[0] = b[0] * c[2] - b[1] * s[2]; rb[1] = b[1] * c[2] + b[0] * s[2];
    rb[2] = b[2] * c[3] - b[3] * s[3]; rb[3] = b[3] * c[3] + b[2] * s[3];
    a = ra; b = rb;
}

struct EpiZ {
    static constexpr bool PERM = true, AFTER_DRAIN = false, HAS_MIDK = false;
    unsigned char* ws; const float* rope; int tok0;
    __device__ __forceinline__ void operator()(const f32x4 (&acc)[2][2][4][2], const pg8::Unit& u, int wr, int wc, int fr, int fq) const {
        unsigned char* ws = this->ws; asm volatile("" : "+s"(ws));
        const int pn = u.pn, row0 = u.pm * 256 + wr * 64 + fr, cl = wc * 32 + 8 * fq;
        if (pn == 12) {
            bf16_t* CQ = (bf16_t*)(ws + WS_CQ); float* SSQ = (float*)(ws + WS_SSQ);
#pragma unroll
            for (int ai = 0; ai < 2; ++ai)
#pragma unroll
                for (int m = 0; m < 4; ++m) { const int r = row0 + ai * 128 + m * 16; float s = 0.f;
#pragma unroll
                    for (int bj = 0; bj < 2; ++bj) { const f32x4 v0 = acc[ai][bj][m][0], v1 = acc[ai][bj][m][1];
                        s += (v0[0] * v0[0] + v0[1] * v0[1]) + (v0[2] * v0[2] + v0[3] * v0[3]) + (v1[0] * v1[0] + v1[1] * v1[1]) + (v1[2] * v1[2] + v1[3] * v1[3]);
                        *(u32x4*)(CQ + (size_t)r * 256 + bj * 128 + cl) = pack8(v0, v1); }
                    s += __shfl_xor(s, 16); s += __shfl_xor(s, 32);
                    if (fq == 0) SSQ[r * 4 + wc] = s; }
        } else if (pn == 13) {
            bf16_t* CKV = (bf16_t*)(ws + WS_CKV); bf16_t* KR = (bf16_t*)(ws + WS_KR); float* SSKV = (float*)(ws + WS_SSKV);
#pragma unroll
            for (int ai = 0; ai < 2; ++ai)
#pragma unroll
                for (int m = 0; m < 4; ++m) { const int r = row0 + ai * 128 + m * 16;
                    const f32x4 v0 = acc[ai][0][m][0], v1 = acc[ai][0][m][1];
                    float s = (v0[0] * v0[0] + v0[1] * v0[1]) + (v0[2] * v0[2] + v0[3] * v0[3]) + (v1[0] * v1[0] + v1[1] * v1[1]) + (v1[2] * v1[2] + v1[3] * v1[3]);
                    *(u32x4*)(CKV + (size_t)r * 128 + cl) = pack8(v0, v1);
                    s += __shfl_xor(s, 16); s += __shfl_xor(s, 32);
                    if (fq == 0) SSKV[r * 4 + wc] = s;
                    if (wc == 0) { f32x4 a = acc[ai][1][m][0], b = acc[ai][1][m][1];
                        const float* rp = rope + (size_t)(tok0 + r) * 32 + 4 * fq;
                        rope8(a, b, *(const f32x4*)rp, *(const f32x4*)(rp + 16));
                        *(u32x4*)(KR + (size_t)r * 32 + 8 * fq) = pack8(a, b); }
                    asm volatile("" ::: "memory"); }
        } else {
            bf16_t* base; int ldc, col; float sc = 1.f; const bool sig = pn < 12;
            if (pn < 12) { base = (bf16_t*)(ws + WS_G); ldc = 3072; col = pn * 256; }
            else if (pn < 17) { base = (bf16_t*)(ws + WS_DQ); ldc = 768; col = (pn - 14) * 256; sc = QSCALE_64; }
            else if (pn < 20) { base = (bf16_t*)(ws + WS_DK); ldc = 768; col = (pn - 17) * 256; }
            else if (pn < 22) { base = (bf16_t*)(ws + WS_DV); ldc = 512; col = (pn - 20) * 256; }
            else if (pn < 24) { base = (bf16_t*)(ws + WS_FQ); ldc = 512; col = (pn - 22) * 256; sc = QSCALE_64; }
            else if (pn < 26) { base = (bf16_t*)(ws + WS_FK); ldc = 512; col = (pn - 24) * 256; }
            else { base = (bf16_t*)(ws + WS_FV); ldc = 512; col = (pn - 26) * 256; }
#pragma unroll
            for (int ai = 0; ai < 2; ++ai)
#pragma unroll
                for (int m = 0; m < 4; ++m) { bf16_t* rowp = base + (size_t)(row0 + ai * 128 + m * 16) * ldc + col + cl;
#pragma unroll
                    for (int bj = 0; bj < 2; ++bj) { f32x4 v0 = acc[ai][bj][m][0] * sc, v1 = acc[ai][bj][m][1] * sc;
                        if (sig) {
#pragma unroll
                            for (int e = 0; e < 4; ++e) { v0[e] = sigmoidf_fast(v0[e]); v1[e] = sigmoidf_fast(v1[e]); } }
                        *(u32x4*)(rowp + bj * 128) = pack8(v0, v1); } }
        }
    }
};

struct EpiUpQ {
    static constexpr bool PERM = true, AFTER_DRAIN = false, HAS_MIDK = false;
    unsigned char* ws; const float* rope; int tok0;
    __device__ __forceinline__ void operator()(const f32x4 (&acc)[2][2][4][2], const pg8::Unit& u, int wr, int wc, int fr, int fq) const {
        unsigned char* ws = this->ws; asm volatile("" : "+s"(ws));
        bf16_t* Q = (bf16_t*)(ws + WS_Q); const float* SSQ = (const float*)(ws + WS_SSQ);
        const int row0 = u.pm * 256 + wr * 64 + fr, cl = wc * 32 + 8 * fq;
#pragma unroll
        for (int ai = 0; ai < 2; ++ai)
#pragma unroll
            for (int m = 0; m < 4; ++m) { const int r = row0 + ai * 128 + m * 16;
                const f32x4 ss = *(const f32x4*)(SSQ + r * 4);
                const float rs = QSCALE_MLA * __builtin_amdgcn_rsqf(((ss[0] + ss[1]) + (ss[2] + ss[3])) * (1.f / 256.f) + EPS);
#pragma unroll
                for (int bj = 0; bj < 2; ++bj) { f32x4 a = acc[ai][bj][m][0] * rs, b = acc[ai][bj][m][1] * rs;
                    const int slab = u.pn * 8 + bj * 4 + wc;
                    if (slab % 3 == 2) { const float* rp = rope + (size_t)(tok0 + r) * 32 + 4 * fq; rope8(a, b, *(const f32x4*)rp, *(const f32x4*)(rp + 16)); }
                    *(u32x4*)(Q + (size_t)r * 768 + u.pn * 256 + bj * 128 + cl) = pack8(a, b); }
                asm volatile("" ::: "memory"); }
    }
};
struct EpiUpKV {
    static constexpr bool PERM = true, AFTER_DRAIN = false, HAS_MIDK = false;
    unsigned char* ws;
    __device__ __forceinline__ void operator()(const f32x4 (&acc)[2][2][4][2], const pg8::Unit& u, int wr, int wc, int fr, int fq) const {
        unsigned char* ws = this->ws; asm volatile("" : "+s"(ws));
        bf16_t* KV = (bf16_t*)(ws + WS_KV); const float* SS = (const float*)(ws + WS_SSKV);
        const int row0 = u.pm * 256 + wr * 64 + fr, cl = wc * 32 + 8 * fq;
#pragma unroll
        for (int ai = 0; ai < 2; ++ai)
#pragma unroll
            for (int m = 0; m < 4; ++m) { const int r = row0 + ai * 128 + m * 16;
                const f32x4 ss = *(const f32x4*)(SS + r * 4);
                const float rs = __builtin_amdgcn_rsqf(((ss[0] + ss[1]) + (ss[2] + ss[3])) * (1.f / 128.f) + EPS);
#pragma unroll
                for (int bj = 0; bj < 2; ++bj) *(u32x4*)(KV + (size_t)r * 1024 + u.pn * 256 + bj * 128 + cl) = pack8(acc[ai][bj][m][0] * rs, acc[ai][bj][m][1] * rs);
                asm volatile("" ::: "memory"); }
    }
};
struct EpiMerge {
    static constexpr bool PERM = true, AFTER_DRAIN = false, HAS_MIDK = true;
    unsigned char* ws; bf16_t* MG;
    static __device__ __forceinline__ void gate8(const bf16_t* p, f32x4& g0, f32x4& g1) { const u32x4 gw = *(const u32x4*)p;
        g0 = (f32x4){bflo(gw.x), bfhi(gw.x), bflo(gw.y), bfhi(gw.y)}; g1 = (f32x4){bflo(gw.z), bfhi(gw.z), bflo(gw.w), bfhi(gw.w)}; }
    __device__ __forceinline__ void midk(f32x4 (&acc)[2][2][4][2], const pg8::Unit& u, int t, int wr, int wc, int fr, int fq) const {
        unsigned char* ws = this->ws; asm volatile("" : "+s"(ws));
        const bf16_t* G = (const bf16_t*)(ws + WS_G) + (t == 8 ? 0 : 1024);
        int zl = 0; asm volatile("" : "+v"(zl));
        const int row0 = u.pm * 256 + wr * 64 + fr + zl, col0 = u.pn * 256 + wc * 32 + 8 * fq;
#pragma unroll
        for (int ai = 0; ai < 2; ++ai)
#pragma unroll
            for (int m = 0; m < 4; ++m) { const int r = row0 + ai * 128 + m * 16;
#pragma unroll
                for (int bj = 0; bj < 2; ++bj) { const bf16_t* gp = G + (size_t)r * 3072 + col0 + bj * 128;
                    f32x4 a0, a1, b0, b1; gate8(gp, a0, a1); gate8(gp + 1024, b0, b1);
#pragma unroll
                    for (int e = 0; e < 4; ++e) { acc[ai][bj][m][0][e] *= a0[e] * __builtin_amdgcn_rcpf(fmaxf(b0[e], 1e-20f)); acc[ai][bj][m][1][e] *= a1[e] * __builtin_amdgcn_rcpf(fmaxf(b1[e], 1e-20f)); }
                    asm volatile("" ::: "memory"); } }
    }
    __device__ __forceinline__ void operator()(const f32x4 (&acc)[2][2][4][2], const pg8::Unit& u, int wr, int wc, int fr, int fq) const {
        unsigned char* ws = this->ws; asm volatile("" : "+s"(ws));
        const bf16_t* G = (const bf16_t*)(ws + WS_G) + 2048;
        const int row0 = u.pm * 256 + wr * 64 + fr, col0 = u.pn * 256 + wc * 32 + 8 * fq;
#pragma unroll
        for (int ai = 0; ai < 2; ++ai)
#pragma unroll
            for (int m = 0; m < 4; ++m) { const int r = row0 + ai * 128 + m * 16;
#pragma unroll
                for (int bj = 0; bj < 2; ++bj) { const int c = col0 + bj * 128; f32x4 g0, g1; gate8(G + (size_t)r * 3072 + c, g0, g1);
#pragma unroll
                    for (int e = 0; e < 4; ++e) { g0[e] = fmaxf(g0[e], 1e-20f); g1[e] = fmaxf(g1[e], 1e-20f); }
                    *(u32x4*)(MG + (size_t)r * 1024 + c) = pack8(acc[ai][bj][m][0] * g0, acc[ai][bj][m][1] * g1); }
                asm volatile("" ::: "memory"); }
    }
};
struct EpiF32 {
    static constexpr bool PERM = false, AFTER_DRAIN = false, HAS_MIDK = false;
    unsigned char* ws;
    __device__ __forceinline__ void operator()(const f32x4 (&acc)[2][2][4][2], const pg8::Unit& u, int wr, int wc, int fr, int fq) const {
        unsigned char* ws = this->ws; asm volatile("" : "+s"(ws));
        float* Y = (float*)(ws + WS_Y); float* SS = (float*)(ws + WS_SSY);
        const int row0 = u.pm * 256 + wr * 64 + fr, col0 = u.pn * 256 + wc * 32 + 4 * fq;
#pragma unroll
        for (int ai = 0; ai < 2; ++ai)
#pragma unroll
            for (int m = 0; m < 4; ++m) { const int r = row0 + ai * 128 + m * 16; float s = 0.f;
#pragma unroll
                for (int bj = 0; bj < 2; ++bj)
#pragma unroll
                    for (int n = 0; n < 2; ++n) { const f32x4 v = acc[ai][bj][m][n]; s += (v[0] * v[0] + v[1] * v[1]) + (v[2] * v[2] + v[3] * v[3]);
                        *(f32x4*)(Y + (size_t)r * 1024 + col0 + bj * 128 + n * 16) = v; }
                s += __shfl_xor(s, 16); s += __shfl_xor(s, 32);
                if (fq == 0) SS[r * 16 + u.pn * 4 + wc] = s; }
    }
};
struct EpiUp {
    static constexpr bool PERM = true, AFTER_DRAIN = false, HAS_MIDK = false;
    unsigned char* ws;
    __device__ __forceinline__ void operator()(const f32x4 (&acc)[2][2][4][2], const pg8::Unit& u, int wr, int wc, int fr, int fq) const {
        unsigned char* ws = this->ws; asm volatile("" : "+s"(ws));
        bf16_t* U = (bf16_t*)(ws + WS_U);
        const int row0 = u.pm * 256 + wr * 64 + fr, col0 = u.pn * 256 + wc * 32 + 8 * fq;
#pragma unroll
        for (int ai = 0; ai < 2; ++ai)
#pragma unroll
            for (int m = 0; m < 4; ++m) { bf16_t* rowp = U + (size_t)(row0 + ai * 128 + m * 16) * FF + col0;
#pragma unroll
                for (int bj = 0; bj < 2; ++bj) { f32x4 v0 = acc[ai][bj][m][0], v1 = acc[ai][bj][m][1];
#pragma unroll
                    for (int e = 0; e < 4; ++e) { const float a = fmaxf(v0[e], 0.f), b = fmaxf(v1[e], 0.f); v0[e] = a * a; v1[e] = b * b; }
                    *(u32x4*)(rowp + bj * 128) = pack8(v0, v1); } }
    }
};

struct AUnit {
    const bf16_t* q; long qs; const bf16_t* k; long ks; const bf16_t* k2; long k2s; const bf16_t* v; long vs;
    bf16_t* o; long os; float* lse; long lses;
    const int* posq; const int* posk; const int* tmm;
    int t0, t1, tq0, dil, bcol;
};
__device__ __forceinline__ int t5_bucket(int rel) {
    const int n = rel < 0 ? -rel : rel;
    const int b = n < 8 ? n : n < 12 ? 8 : n < 16 ? 9 : n < 23 ? 10 : n < 32 ? 11 : n < 46 ? 12 : n < 64 ? 13 : n < 91 ? 14 : 15;
    return b + (rel > 0 ? 16 : 0);
}
__device__ __forceinline__ int crow(int r, int hi) { return (r & 3) + 8 * (r >> 2) + 4 * hi; }
__device__ __forceinline__ int clamp128(int v) { return (v < -128 ? -128 : (v > 128 ? 128 : v)) + 128; }
typedef short v4i16_t __attribute__((ext_vector_type(4)));
__device__ __forceinline__ s16x4 vtr(const LAS unsigned char* p) { return __builtin_bit_cast(s16x4, __builtin_amdgcn_ds_read_tr16_b64_v4i16((LAS v4i16_t*)p)); }
__device__ __forceinline__ float max3f(float a, float b, float c) { float r; asm("v_max3_f32 %0, %1, %2, %3" : "=v"(r) : "v"(a), "v"(b), "v"(c)); return r; }
__device__ __forceinline__ float xhalf_max(float m) { auto rr = __builtin_amdgcn_permlane32_swap(__float_as_uint(m), __float_as_uint(m), false, false); return fmaxf(__uint_as_float(rr[0]), __uint_as_float(rr[1])); }
__device__ __forceinline__ float xhalf_sum(float m) { auto rr = __builtin_amdgcn_permlane32_swap(__float_as_uint(m), __float_as_uint(m), false, false); return __uint_as_float(rr[0]) + __uint_as_float(rr[1]); }


template <int MODE, int NS, int NB, int KP, int VP>
__device__ __forceinline__ void attn_tile(const LAS unsigned char* kbase, const LAS unsigned char* vbase, int t, const bf16x8 (&qf)[NS], f32x16& negm, float& m_ref, float& l_run, bool& first, f32x16 (&O)[NB],
                                          int pq, int qmin, int qmax, int tq, int wt0, int wt1, int dil, const LAS float* btab, const LAS int* posl, const LAS int* tml, int lane, int q, int hi) {
    constexpr float THR = 8.f; constexpr bool USE_NEGM = MODE == 0;
        if (MODE != 2 || (t >= wt0 && t <= wt1)) {
            const LAS unsigned char* kb = kbase + q * KP + hi * 16;
            f32x16 p0, p1;
            { bf16x8 ka[NS], kc[NS];
#pragma unroll
              for (int s = 0; s < NS; ++s) { ka[s] = *(const LAS bf16x8*)(kb + s * 32); kc[s] = *(const LAS bf16x8*)(kb + 32 * KP + s * 32); }
              if (USE_NEGM) { p0 = __builtin_amdgcn_mfma_f32_32x32x16_bf16(ka[0], qf[0], negm, 0, 0, 0); p1 = __builtin_amdgcn_mfma_f32_32x32x16_bf16(kc[0], qf[0], negm, 0, 0, 0); }
              else { const f32x16 z = {0.f, 0.f, 0.f, 0.f, 0.f, 0.f, 0.f, 0.f, 0.f, 0.f, 0.f, 0.f, 0.f, 0.f, 0.f, 0.f};
                     p0 = __builtin_amdgcn_mfma_f32_32x32x16_bf16(ka[0], qf[0], z, 0, 0, 0); p1 = __builtin_amdgcn_mfma_f32_32x32x16_bf16(kc[0], qf[0], z, 0, 0, 0); }
#pragma unroll
              for (int s = 1; s < NS; ++s) {
                p0 = __builtin_amdgcn_mfma_f32_32x32x16_bf16(ka[s], qf[s], p0, 0, 0, 0);
                p1 = __builtin_amdgcn_mfma_f32_32x32x16_bf16(kc[s], qf[s], p1, 0, 0, 0); } }
            if (MODE == 0) asm volatile("s_nop 15\n\ts_nop 7" : "+v"(p0), "+v"(p1));
            const LAS unsigned char* vb = vbase + (4 * hi + ((lane & 15) >> 2)) * VP + ((lane >> 4) & 1) * 32 + (lane & 3) * 8;
            s16x4 vlo[NB], vhi[NB];
#pragma unroll
            for (int b = 0; b < NB; ++b) { vlo[b] = vtr(vb + b * 64); vhi[b] = vtr(vb + 8 * VP + b * 64); }
            if (MODE == 1) {
                const int kmin = __builtin_amdgcn_readfirstlane(tml[2 * t]), kmax = __builtin_amdgcn_readfirstlane(tml[2 * t + 1]);
                if (kmin - qmax >= 128) { const float c = btab[256] - m_ref;
#pragma unroll
                    for (int r = 0; r < 16; ++r) { p0[r] += c; p1[r] += c; } }
                else if (kmax - qmin <= -128) { const float c = btab[0] - m_ref;
#pragma unroll
                    for (int r = 0; r < 16; ++r) { p0[r] += c; p1[r] += c; } }
                else {
#pragma unroll
                    for (int r = 0; r < 16; ++r) { const int kv = 64 * t + crow(r, hi); const int a = posl[kv], b = posl[kv + 32];
                        p0[r] += btab[clamp128(a - pq)] - m_ref; p1[r] += btab[clamp128(b - pq)] - m_ref; } }
            }
            if (MODE == 2) {
#pragma unroll
                for (int r = 0; r < 16; ++r) { const int rel0 = 64 * t + crow(r, hi) - tq, rel1 = rel0 + 32;
                    const float b0 = btab[clamp128(rel0 * dil)] - m_ref, b1 = btab[clamp128(rel1 * dil)] - m_ref;
                    p0[r] = (rel0 >= -64 && rel0 <= 64) ? p0[r] + b0 : -INFINITY;
                    p1[r] = (rel1 >= -64 && rel1 <= 64) ? p1[r] + b1 : -INFINITY; }
            }
            float mx;
            { float a = max3f(p0[0], p0[1], p1[0]), b = max3f(p0[2], p0[3], p1[1]); a = max3f(a, p1[2], p1[3]);
#pragma unroll
              for (int r = 4; r < 16; r += 4) { a = max3f(a, p0[r], p0[r + 1]); b = max3f(b, p0[r + 2], p0[r + 3]); a = max3f(a, p1[r], p1[r + 1]); b = max3f(b, p1[r + 2], p1[r + 3]); }
              mx = xhalf_max(fmaxf(a, b)); }
            if (first || __any(mx > THR)) {
                float dl = first ? (mx > -1e30f ? mx : 0.f) : fmaxf(mx, 0.f);
                first = false;
                m_ref += dl;
#pragma unroll
                for (int r = 0; r < 16; ++r) { p0[r] -= dl; p1[r] -= dl; if (USE_NEGM) negm[r] = -m_ref; }
                const float f = __builtin_amdgcn_exp2f(-dl);
                l_run *= f;
#pragma unroll
                for (int b = 0; b < NB; ++b)
#pragma unroll
                    for (int r = 0; r < 16; ++r) O[b][r] *= f;
            }
            float ls0 = 0.f, ls1 = 0.f;
#pragma unroll
            for (int r = 0; r < 16; ++r) { p0[r] = __builtin_amdgcn_exp2f(p0[r]); p1[r] = __builtin_amdgcn_exp2f(p1[r]); }
#pragma unroll
            for (int r = 0; r < 16; r += 4) { ls0 += p0[r]; ls1 += p1[r]; ls0 += p0[r + 1]; ls1 += p1[r + 1]; ls0 += p0[r + 2]; ls1 += p1[r + 2]; ls0 += p0[r + 3]; ls1 += p1[r + 3]; asm volatile("" : "+v"(ls0), "+v"(ls1)); }
            l_run += ls0 + ls1;
            bf16x8 pw[4];
            { u32x4 w;
              w.x = pk2(p0[0], p0[1]); w.y = pk2(p0[2], p0[3]); w.z = pk2(p0[4], p0[5]); w.w = pk2(p0[6], p0[7]); pw[0] = __builtin_bit_cast(bf16x8, w);
              w.x = pk2(p0[8], p0[9]); w.y = pk2(p0[10], p0[11]); w.z = pk2(p0[12], p0[13]); w.w = pk2(p0[14], p0[15]); pw[1] = __builtin_bit_cast(bf16x8, w);
              w.x = pk2(p1[0], p1[1]); w.y = pk2(p1[2], p1[3]); w.z = pk2(p1[4], p1[5]); w.w = pk2(p1[6], p1[7]); pw[2] = __builtin_bit_cast(bf16x8, w);
              w.x = pk2(p1[8], p1[9]); w.y = pk2(p1[10], p1[11]); w.z = pk2(p1[12], p1[13]); w.w = pk2(p1[14], p1[15]); pw[3] = __builtin_bit_cast(bf16x8, w); }
#pragma unroll
            for (int ks = 0; ks < 4; ++ks) {
                s16x4 nlo[NB], nhi[NB];
                if (ks < 3) {
#pragma unroll
                    for (int b = 0; b < NB; ++b) { nlo[b] = vtr(vb + (ks + 1) * 16 * VP + b * 64); nhi[b] = vtr(vb + ((ks + 1) * 16 + 8) * VP + b * 64); } }
#pragma unroll
                for (int b = 0; b < NB; ++b) { const bf16x8 vf = {vlo[b][0], vlo[b][1], vlo[b][2], vlo[b][3], vhi[b][0], vhi[b][1], vhi[b][2], vhi[b][3]};
                    O[b] = __builtin_amdgcn_mfma_f32_32x32x16_bf16(vf, pw[ks], O[b], 0, 0, 0); }
                if (ks < 3) {
#pragma unroll
                    for (int b = 0; b < NB; ++b) { vlo[b] = nlo[b]; vhi[b] = nhi[b]; } }
            }
        }
}

template <int MODE>
__device__ __forceinline__ void attn_unit(LAS unsigned char* lds, const AUnit& U, const float* __restrict__ rel_bias) {
    constexpr int DQK = MODE == 0 ? 96 : 64, DV = MODE == 0 ? 64 : 128;
    constexpr int KP = DQK * 2 + 16, VP = MODE == 0 ? 192 : 320;
    constexpr int KCPR = DQK / 8, VCPR = DV / 8, NKC = 64 * KCPR, NVC = 64 * VCPR, NS = DQK / 16, NB = DV / 32;
    constexpr int KBUF = 64 * 208, VBUF = 64 * 320, K_OFF = 0, V_OFF = 2 * KBUF, BT_OFF = V_OFF + 2 * VBUF;
    int tid = threadIdx.x; asm volatile("" : "+v"(tid));
    const int lane = tid & 63, wid = __builtin_amdgcn_readfirstlane(tid >> 6), q = lane & 31, hi = lane >> 5;
    LAS float* btab = (LAS float*)(lds + BT_OFF);
    if (MODE != 0) { for (int i = tid; i < 257; i += 512) btab[i] = LOG2E * rel_bias[t5_bucket(i - 128) * 20 + U.bcol]; }
    constexpr int POS_OFF = BT_OFF + 1040, TM_OFF = POS_OFF + 4 * SEQ;
    LAS int* posl = (LAS int*)(lds + POS_OFF); LAS int* tml = (LAS int*)(lds + TM_OFF);
    if (MODE == 1) { for (int i = tid; i < SEQ; i += 512) posl[i] = U.posk[i]; if (tid < 128) tml[tid] = U.tmm[tid]; }
    const bf16_t* src[3]; int dst[3];
    { const int row = tid >> 3, cc = tid & 7;
      src[0] = U.k + (long)row * U.ks + cc * 8 + (long)U.t0 * 64 * U.ks; dst[0] = K_OFF + row * KP + cc * 16;
      if (MODE == 0) {
          src[1] = U.v + (long)row * U.vs + cc * 8 + (long)U.t0 * 64 * U.vs; dst[1] = V_OFF + row * VP + cc * 16;
          const int r2 = (tid & 255) >> 2, c2 = tid & 3;
          src[2] = U.k2 + (long)r2 * U.k2s + c2 * 8 + (long)U.t0 * 64 * U.k2s; dst[2] = K_OFF + r2 * KP + 128 + c2 * 16;
      } else {
#pragma unroll
          for (int s = 1; s < 3; ++s) { const int c2 = tid + 512 * (s - 1), r2 = c2 >> 4, c3 = c2 & 15;
              src[s] = U.v + (long)r2 * U.vs + c3 * 8 + (long)U.t0 * 64 * U.vs; dst[s] = V_OFF + r2 * VP + c3 * 16; }
      } }
    const long step0 = 64 * U.ks, step1 = MODE == 0 ? 64 * U.vs : 64 * U.vs, step2 = MODE == 0 ? 64 * U.k2s : 64 * U.vs;
    const bool s2ok = MODE != 0 || tid < 256;
    const bf16_t* qrow = U.q + (long)(wid * 32 + q) * U.qs;
    bf16x8 qf[NS];
#pragma unroll
    for (int s = 0; s < NS; ++s) qf[s] = *(const bf16x8*)(qrow + 16 * s + 8 * hi);
    int pq = 0, qmin = 0, qmax = 0;
    if (MODE == 1) { pq = U.posq[wid * 32 + q]; qmin = pq; qmax = pq;
#pragma unroll
        for (int o = 1; o < 32; o <<= 1) { qmin = min(qmin, __shfl_xor(qmin, o)); qmax = max(qmax, __shfl_xor(qmax, o)); } }
    const int tq = U.tq0 + wid * 32 + q;
    const int wt0 = (U.tq0 >> 6) + (wid >> 1) - 1, wt1 = wt0 + 2;
    constexpr float THR = 8.f; constexpr bool USE_NEGM = MODE == 0;
    float m_ref = 0.f, l_run = 0.f; bool first = true;
    f32x16 negm;
#pragma unroll
    for (int r = 0; r < 16; ++r) negm[r] = 0.f;
    f32x16 O[NB];
#pragma unroll
    for (int b = 0; b < NB; ++b)
#pragma unroll
        for (int r = 0; r < 16; ++r) O[b][r] = 0.f;
    u32x4 sa[3], sb[3];
    const int nt = U.t1 - U.t0;
#define ATT_LOAD(S) do { S[0] = *(const u32x4*)src[0]; S[1] = *(const u32x4*)src[1]; S[2] = *(const u32x4*)src[2]; src[0] += step0; src[1] += step1; src[2] += step2; } while (0)
#define ATT_STORE(S, B) do { const int kb1_ = (B) * KBUF, vb1_ = (B) * VBUF; *(LAS u32x4*)(lds + dst[0] + kb1_) = S[0]; *(LAS u32x4*)(lds + dst[1] + vb1_) = S[1]; \
        if (s2ok) *(LAS u32x4*)(lds + dst[2] + (MODE == 0 ? kb1_ : vb1_)) = S[2]; } while (0)
#define ATT_TILE(B, T) attn_tile<MODE, NS, NB, KP, VP>(lds + K_OFF + (B) * KBUF, lds + V_OFF + (B) * VBUF, (T), qf, negm, m_ref, l_run, first, O, pq, qmin, qmax, tq, wt0, wt1, U.dil, btab, posl, tml, lane, q, hi)
    ATT_LOAD(sa);
    if (nt > 1) ATT_LOAD(sb);
    ATT_STORE(sa, 0);
    __syncthreads();
    for (int i = 0; i < nt; i += 2) {
        if (i + 2 < nt) ATT_LOAD(sa);
        ATT_TILE(0, U.t0 + i);
        if (i + 1 < nt) ATT_STORE(sb, 1);
        __syncthreads();
        if (i + 1 >= nt) break;
        if (i + 3 < nt) ATT_LOAD(sb);
        ATT_TILE(1, U.t0 + i + 1);
        if (i + 2 < nt) ATT_STORE(sa, 0);
        __syncthreads();
    }
#undef ATT_LOAD
#undef ATT_STORE
#undef ATT_TILE
    const float m_run = m_ref;
    const float l_tot = xhalf_sum(l_run), inv = 1.f / l_tot;
    bf16_t* orow = U.o + (long)(wid * 32 + q) * U.os;
#pragma unroll
    for (int b = 0; b < NB; ++b)
#pragma unroll
        for (int g4 = 0; g4 < 4; ++g4) { u32x2 w; w.x = pk2(O[b][4 * g4] * inv, O[b][4 * g4 + 1] * inv); w.y = pk2(O[b][4 * g4 + 2] * inv, O[b][4 * g4 + 3] * inv);
            *(u32x2*)(orow + 32 * b + 8 * g4 + 4 * hi) = w; }
    if (MODE == 2) { if (hi == 0) U.lse[(long)(wid * 32 + q) * U.lses] = m_run + log2f(l_tot); }
}

struct Params { const float* in[21]; float* out; unsigned char* ws; double inv[16]; float lam_init[4]; int ph_lo, ph_hi; };
enum { I_X = 0, I_POS, I_RELB, I_GMIXPRE, I_WIN, I_GQ, I_WUQ, I_GKV, I_WUKV, I_LQ1, I_LK1, I_LQ2, I_LK2, I_GDIFF, I_WBR, I_WOUT, I_GMIXPOST, I_GMLPPRE, I_WUP, I_WDN, I_GMLPPOST };
constexpr int LDS_BYTES = 147456;

__device__ __forceinline__ void transpose_item(const float* __restrict__ W, int ldw, int srccol0, bool inter, const float* __restrict__ kscale, bf16_t* WT, int K, int drow0, int k0, LAS float* scr, int lane) {
    const int c = lane & 31, sc = inter ? ((c & 1) * 16 + (c >> 1)) : c;
#pragma unroll 8
    for (int i = 0; i < 32; ++i) { const int kk = 2 * i + (lane >> 5); float v = 0.f;
        if (srccol0 >= 0) { v = W[(size_t)(k0 + kk) * ldw + srccol0 + sc]; if (kscale) v *= kscale[k0 + kk]; }
        scr[kk * 33 + c] = v; }
    asm volatile("s_waitcnt lgkmcnt(0)" ::: "memory");
    const int ch = lane & 7;
#pragma unroll
    for (int j = 0; j < 4; ++j) { const int n = (lane >> 3) + 8 * j; const LAS float* s = scr + (8 * ch) * 33 + n;
        u32x4 o; o.x = pk2(s[0 * 33], s[1 * 33]); o.y = pk2(s[2 * 33], s[3 * 33]); o.z = pk2(s[4 * 33], s[5 * 33]); o.w = pk2(s[6 * 33], s[7 * 33]);
        *(u32x4*)(WT + (size_t)(drow0 + n) * K + k0 + 8 * ch) = o; }
    asm volatile("s_waitcnt lgkmcnt(0)" ::: "memory");
}
__device__ __forceinline__ void convert_layer(const Params& p, int l, LAS unsigned char* lds, int gw, int NGW, int wave, int lane) {
    LAS float* scr = (LAS float*)(lds + wave * 16384);
    unsigned char* ws = p.ws;
    constexpr int I_IN = 16 * 224, I_UQ = 4 * 24, I_UKV = 2 * 32, I_BR = 3 * 8 * 32, I_OUT = 16 * 32, I_UP = 16 * 128, I_DN = 64 * 32;
    constexpr int NIT = I_IN + I_UQ + I_UKV + I_BR + I_OUT + I_UP + I_DN;
    for (int it = gw; it < NIT; it += NGW) {
        int r = it;
        if (r < I_IN) { const int kb = r / 224, nb = r % 224, n = nb * 32; int sc; bool inter = false;
            if (n < 3072) sc = 4000 + n; else if (n < 3328) sc = n - 3072; else if (n < 3456) sc = 256 + (n - 3328); else if (n < 3488) { sc = 384; inter = true; } else if (n < 3584) sc = -1; else sc = n - 3168;
            transpose_item(p.in[I_WIN] + (size_t)l * DM * INC, INC, sc, inter, nullptr, (bf16_t*)(ws + WS_WIN), DM, n, kb * 64, scr, lane); continue; }
        r -= I_IN;
        if (r < I_UQ) { const int kb = r / 24, nb = r % 24;
            transpose_item(p.in[I_WUQ] + (size_t)l * 256 * 768, 768, nb * 32, (nb % 3) == 2, p.in[I_GQ] + l * 256, (bf16_t*)(ws + WS_WUQ), 256, nb * 32, kb * 64, scr, lane); continue; }
        r -= I_UQ;
        if (r < I_UKV) { const int kb = r / 32, nb = r % 32;
            transpose_item(p.in[I_WUKV] + (size_t)l * 128 * 1024, 1024, nb * 32, false, p.in[I_GKV] + l * 128, (bf16_t*)(ws + WS_WUKV), 128, nb * 32, kb * 64, scr, lane); continue; }
        r -= I_UKV;
        if (r < I_BR) { const int b = r / 256, r2 = r % 256, kb = r2 / 32, nb = r2 % 32;
            transpose_item(p.in[I_WBR] + (size_t)l * 3 * 512 * 1024, 1024, nb * 32, false, nullptr, (bf16_t*)(ws + WS_WBR), 1536, nb * 32, b * 512 + kb * 64, scr, lane); continue; }
        r -= I_BR;
        if (r < I_OUT) { const int kb = r / 32, nb = r % 32;
            transpose_item(p.in[I_WOUT] + (size_t)l * DM * DM, DM, nb * 32, false, nullptr, (bf16_t*)(ws + WS_WOUT), DM, nb * 32, kb * 64, scr, lane); continue; }
        r -= I_OUT;
        if (r < I_UP) { const int kb = r / 128, nb = r % 128;
            transpose_item(p.in[I_WUP] + (size_t)l * DM * FF, FF, nb * 32, false, nullptr, (bf16_t*)(ws + WS_WUP), DM, nb * 32, kb * 64, scr, lane); continue; }
        r -= I_UP;
        { const int kb = r / 32, nb = r % 32;
            transpose_item(p.in[I_WDN] + (size_t)l * FF * DM, DM, nb * 32, false, nullptr, (bf16_t*)(ws + WS_WDN), FF, nb * 32, kb * 64, scr, lane); }
    }
}
__device__ __forceinline__ void norm_row(const float* xsrc, float* xdst, const float* y, const float* ssy, const float* gpost, const float* gpre, bf16_t* xn, int lane) {
    f32x4 v[4];
#pragma unroll
    for (int j = 0; j < 4; ++j) v[j] = *(const f32x4*)(xsrc + 4 * lane + 256 * j);
    if (y) {
        float s = 0.f;
#pragma unroll
        for (int k = 0; k < 16; ++k) s += ssy[k];
        const float rs = 1.f / sqrtf(s * (1.f / 1024.f) + EPS);
#pragma unroll
        for (int j = 0; j < 4; ++j) { const f32x4 yy = *(const f32x4*)(y + 4 * lane + 256 * j), g = *(const f32x4*)(gpost + 4 * lane + 256 * j);
            v[j] += yy * rs * g; *(f32x4*)(xdst + 4 * lane + 256 * j) = v[j]; }
    }
    if (xn) {
        float s2 = 0.f;
#pragma unroll
        for (int j = 0; j < 4; ++j) s2 += (v[j][0] * v[j][0] + v[j][1] * v[j][1]) + (v[j][2] * v[j][2] + v[j][3] * v[j][3]);
        const float rs = 1.f / sqrtf(wave_sum(s2) * (1.f / 1024.f) + EPS);
#pragma unroll
        for (int j = 0; j < 4; ++j) { const f32x4 g = *(const f32x4*)(gpre + 4 * lane + 256 * j); const f32x4 o = v[j] * rs * g;
            u32x2 w; w.x = pk2(o[0], o[1]); w.y = pk2(o[2], o[3]); *(u32x2*)(xn + 4 * lane + 256 * j) = w; }
    }
}


typedef unsigned v4u __attribute__((ext_vector_type(4)));
#define XB_TMO      128
#define XB_XCNT(j)  (256  + 64 * (j))
#define XB_XSUB(j)  (1280 + 64 * (j))
#define XB_XGEN(j)  (2304 + 64 * (j))
#define XB_TOP      3328
#define XB_TOPGEN   3392
#define XCD_BAR_WORDS 3456
#define XB_SPIN_CAP (1u << 18)

__device__ __forceinline__ unsigned xb_ld(unsigned* p)              { return __hip_atomic_load(p, __ATOMIC_RELAXED, __HIP_MEMORY_SCOPE_AGENT); }
__device__ __forceinline__ unsigned xb_add(unsigned* p, unsigned v) { return __hip_atomic_fetch_add(p, v, __ATOMIC_RELAXED, __HIP_MEMORY_SCOPE_AGENT); }
__device__ __forceinline__ unsigned xb_xcc_id() { return (unsigned)__builtin_amdgcn_s_getreg((3 << 11) | 20) & 0xFu; }
#define XB_SPIN(cond, bar) do { unsigned _sp = 0; while (cond) { __builtin_amdgcn_s_sleep(1); \
    if ((++_sp & 255u) == 0u) { if (xb_ld(&(bar)[XB_TMO])) break; if (_sp > XB_SPIN_CAP) { atomicAdd(&(bar)[XB_TMO], 1u); break; } } } } while (0)

struct XcdBarrier {
    unsigned* bar; unsigned x;
    volatile LAS unsigned* st;
};

__device__ __forceinline__ XcdBarrier xcd_barrier_post(unsigned* bar, volatile LAS unsigned* st) {
    XcdBarrier b; b.bar = bar; b.x = xb_xcc_id(); b.st = st;
    if (threadIdx.x == 0) (void)xb_add(&bar[XB_XCNT(b.x)], 1u);
    return b;
}
__device__ __forceinline__ void xcd_barrier_complete(unsigned* bar, unsigned x, unsigned& nloc, unsigned& nx) {
    const unsigned G = gridDim.x * gridDim.y * gridDim.z;
    unsigned sum, cnt, mine, sp = 0u;
    for (;;) {
        sum = 0u; cnt = 0u; mine = 0u;
#pragma unroll
        for (unsigned j = 0; j < 16; ++j) { const unsigned c = xb_ld(&bar[XB_XCNT(j)]); sum += c; cnt += (c > 0u) ? 1u : 0u; mine = (j == x) ? c : mine; }
        if (sum == G) break;
        __builtin_amdgcn_s_sleep(1);
        if ((++sp & 255u) == 0u) { if (xb_ld(&bar[XB_TMO])) break; if (sp > XB_SPIN_CAP) { atomicAdd(&bar[XB_TMO], 1u); break; } }
    }
    nloc = mine > 0u ? mine : 1u; nx = cnt > 0u ? cnt : 1u;
}

__device__ __forceinline__ void xcd_barrier(const XcdBarrier& b) {
    asm volatile("s_waitcnt vmcnt(0)" ::: "memory");
    __syncthreads();
    if (threadIdx.x == 0) {
        unsigned* bar = b.bar;
        __builtin_amdgcn_s_waitcnt(0);
        unsigned nloc = b.st[0], nx = b.st[1];
        if (nloc == 0u) { xcd_barrier_complete(bar, b.x, nloc, nx); b.st[0] = nloc; b.st[1] = nx; }
        const unsigned old = xb_add(&bar[XB_XSUB(b.x)], 1u);
        const unsigned gen = old / nloc;
        if (old + 1u == (gen + 1u) * nloc) {
            __builtin_amdgcn_fence(__ATOMIC_RELEASE, "agent");
            asm volatile("s_waitcnt vmcnt(0)" ::: "memory");
            const unsigned og = xb_add(&bar[XB_TOP], 1u);
            const unsigned tg = og / nx;
            if (og + 1u == (tg + 1u) * nx) xb_add(&bar[XB_TOPGEN], 1u);
            else XB_SPIN(xb_ld(&bar[XB_TOPGEN]) == tg, bar);
            __builtin_amdgcn_fence(__ATOMIC_ACQUIRE, "agent");
            xb_add(&bar[XB_XGEN(b.x)], 1u);
            asm volatile("s_waitcnt vmcnt(0)" ::: "memory");
        } else {
            XB_SPIN(xb_ld(&bar[XB_XGEN(b.x)]) == gen, bar);
            __builtin_amdgcn_fence(__ATOMIC_ACQUIRE, "agent");
            asm volatile("s_waitcnt vmcnt(0)" ::: "memory");
        }
    }
    __syncthreads();
}

__global__ void __launch_bounds__(512, 2) fwd_megakernel(Params p) {
    extern __shared__ __attribute__((aligned(16))) unsigned char lds_raw[];
    LAS unsigned char* lds = (LAS unsigned char*)lds_raw;
    cg::grid_group grid = cg::this_grid();
    volatile LAS unsigned* xst = (volatile LAS unsigned*)(lds + 131072 + 64);
    if (threadIdx.x < 2) xst[threadIdx.x] = 0u;
    __syncthreads();
    XcdBarrier xbar; xbar.bar = (unsigned*)p.ws; xbar.x = 0; xbar.st = xst;
    for (int ph = p.ph_lo; ph < p.ph_hi; ++ph) {
    int tid = threadIdx.x; asm volatile("" : "+v"(tid) :: "memory");
    const int lane = tid & 63, wave = __builtin_amdgcn_readfirstlane(tid >> 6);
    const int G = gridDim.x, gw = blockIdx.x * 8 + wave, NGW = G * 8;
    unsigned char* ws = p.ws;
    const int* pos = (const int*)p.in[I_POS];

    if (ph == 0) {
        if (blockIdx.x == 0) for (int i = tid; i < 4096; i += 512) __hip_atomic_store((unsigned*)p.ws + i, 0u, __ATOMIC_RELAXED, __HIP_MEMORY_SCOPE_AGENT);
        convert_layer(p, 0, lds, gw, NGW, wave, lane);
        float* rope = (float*)(ws + WS_ROPE);
        for (int i = blockIdx.x * 512 + tid; i < MALL * 16; i += G * 512) { const int tok = i >> 4, f = i & 15;
            const double rev = (double)pos[tok] * p.inv[f] * 0.15915494309189535; const float fr = (float)(rev - floor(rev));
            rope[tok * 32 + f] = __builtin_amdgcn_cosf(fr); rope[tok * 32 + 16 + f] = __builtin_amdgcn_sinf(fr); }
        int* tmm = (int*)(ws + WS_TMM);
        for (int i = gw; i < BATCH * 64; i += NGW) { int v = pos[i * 64 + lane], mn = v, mx = v;
#pragma unroll
            for (int o = 1; o < 64; o <<= 1) { mn = min(mn, __shfl_xor(mn, o)); mx = max(mx, __shfl_xor(mx, o)); }
            if (lane == 0) { tmm[2 * i] = mn; tmm[2 * i + 1] = mx; } }
        for (int r = gw; r < MALL; r += NGW)
            norm_row(p.in[I_X] + (size_t)r * DM, nullptr, nullptr, nullptr, nullptr, p.in[I_GMIXPRE], (bf16_t*)(ws + WS_XN) + (size_t)r * DM, lane);
    } else {
            const int pq_ = ph - 1, l = pq_ / 20, c = (pq_ / 10) & 1, kind = pq_ % 10;
            bf16_t* XN = (bf16_t*)(ws + WS_XN) + (size_t)c * MC * DM;
            const int tok0 = c * MC;
            const float* rope = (const float*)(ws + WS_ROPE);
            if (kind == 0) {
                pg8::Gemm g{XN, (const bf16_t*)(ws + WS_WIN), MC, NZ, DM, DM, DM}; pg8::StaticOrder S; S.init(MC, NZ, G, (int)blockIdx.x);
                EpiZ E{ws, rope, tok0};
                pg8::gemm_phase<EpiZ, pg8::StaticOrder, true, true>(lds, g, S, E);
            }
            else if (kind == 1) {
                { pg8::Gemm g{(const bf16_t*)(ws + WS_CQ), (const bf16_t*)(ws + WS_WUQ), MC, 768, 256, 256, 256}; pg8::StaticOrder S; S.init(MC, 768, G, (int)blockIdx.x);
                  EpiUpQ E{ws, rope, tok0}; pg8::gemm_phase<EpiUpQ, pg8::StaticOrder, true, true>(lds, g, S, E); }
                { pg8::Gemm g{(const bf16_t*)(ws + WS_CKV), (const bf16_t*)(ws + WS_WUKV), MC, 1024, 128, 128, 128}; pg8::StaticOrder S; S.init(MC, 1024, G, (int)blockIdx.x);
                  EpiUpKV E{ws}; pg8::gemm_phase<EpiUpKV, pg8::StaticOrder, true, true>(lds, g, S, E); }
            }
            else if (kind == 2) {
                const float* relb = p.in[I_RELB];
                for (int u = blockIdx.x; u < 1792; u += G) {
                    AUnit U{};
                    if (u < 512) {
                        const int qb = u & 15, h = (u >> 4) & 3, m = (u >> 6) & 1, b = u >> 7; const long row0 = (long)b * SEQ;
                        U.q = (const bf16_t*)(ws + WS_FQ) + (row0 + 256 * qb) * 512 + (m * 4 + h) * 64; U.qs = 512;
                        U.k = (const bf16_t*)(ws + WS_FK) + row0 * 512 + (m * 4 + h) * 64; U.ks = 512; U.k2 = U.k; U.k2s = 0;
                        U.v = (const bf16_t*)(ws + WS_FV) + row0 * 512 + h * 128; U.vs = 512;
                        U.o = XN + ((long)m * MC + row0 + 256 * qb) * 512 + h * 128; U.os = 512;
                        U.posq = pos + tok0 + row0 + 256 * qb; U.posk = pos + tok0 + row0; U.tmm = (const int*)(ws + WS_TMM) + (c * CB + b) * 128;
                        U.t0 = 0; U.t1 = 64; U.bcol = 12 + m * 4 + h;
                        attn_unit<1>(lds, U, relb);
                    } else if (u < 1024) {
                        const int v = u - 512, qb = v & 15, h = (v >> 4) & 7, b = v >> 7; const long row0 = (long)b * SEQ;
                        U.q = (const bf16_t*)(ws + WS_Q) + (row0 + 256 * qb) * 768 + h * 96; U.qs = 768;
                        U.k = (const bf16_t*)(ws + WS_KV) + row0 * 1024 + h * 128; U.ks = 1024;
                        U.k2 = (const bf16_t*)(ws + WS_KR) + row0 * 32; U.k2s = 32;
                        U.v = (const bf16_t*)(ws + WS_KV) + row0 * 1024 + h * 128 + 64; U.vs = 1024;
                        U.o = (bf16_t*)(ws + WS_OA) + (row0 + 256 * qb) * 1536 + h * 64; U.os = 1536;
                        U.t0 = 0; U.t1 = 64;
                        attn_unit<0>(lds, U, relb);
                    } else {
                        const int v = u - 1024, u16 = v & 15, g = (v >> 4) % 3, bh = (v >> 4) / 3, h = bh & 3, b = bh >> 2;
                        const int dil = g == 0 ? 1 : (g == 1 ? 4 : 16), L = SEQ / dil, nblk = L / 256, rr = u16 / nblk, nb = u16 % nblk;
                        const long base = (long)b * SEQ + rr, qrow0 = base + (long)256 * nb * dil;
                        U.q = (const bf16_t*)(ws + WS_DQ) + qrow0 * 768 + (g * 4 + h) * 64; U.qs = 768L * dil;
                        U.k = (const bf16_t*)(ws + WS_DK) + base * 768 + (g * 4 + h) * 64; U.ks = 768L * dil; U.k2 = U.k; U.k2s = 0;
                        U.v = (const bf16_t*)(ws + WS_DV) + base * 512 + h * 128; U.vs = 512L * dil;
                        U.o = (bf16_t*)(ws + WS_PB) + ((long)g * MC + qrow0) * 512 + h * 128; U.os = 512L * dil;
                        U.lse = (float*)(ws + WS_LSE) + ((long)g * MC + qrow0) * 4 + h; U.lses = 4L * dil;
                        U.t0 = max(0, 4 * nb - 1); U.t1 = min(L / 64, 4 * nb + 5); U.tq0 = 256 * nb; U.dil = dil; U.bcol = g * 4 + h;
                        attn_unit<2>(lds, U, relb);
                    }
                }
            }
            else if (kind == 3) {
                const float a1 = wave_sum(p.in[I_LQ1][l * 64 + lane] * p.in[I_LK1][l * 64 + lane]), a2 = wave_sum(p.in[I_LQ2][l * 64 + lane] * p.in[I_LK2][l * 64 + lane]);
                const float lam_init = p.lam_init[l], lam = expf(a1) - expf(a2) + lam_init, osc = 1.f - lam_init;
                const bf16_t* PB = (const bf16_t*)(ws + WS_PB); const float* LSE = (const float*)(ws + WS_LSE);
                bf16_t* OB = (bf16_t*)(ws + WS_OA) + 512; bf16_t* OC = OB + 512;
                const float* gs = p.in[I_GDIFF] + l * 128 + (lane & 15) * 8;
                const f32x4 gs0 = *(const f32x4*)gs, gs1 = *(const f32x4*)(gs + 4);
                for (int r = gw; r < MC; r += NGW) {
                    const int h = lane >> 4;
                    const float l0 = LSE[(size_t)r * 4 + h], l1 = LSE[((size_t)MC + r) * 4 + h], l2 = LSE[((size_t)2 * MC + r) * 4 + h];
                    const float mx = fmaxf(l0, fmaxf(l1, l2));
                    float w0 = __builtin_amdgcn_exp2f(l0 - mx), w1 = __builtin_amdgcn_exp2f(l1 - mx), w2 = __builtin_amdgcn_exp2f(l2 - mx);
                    const float wi = 1.f / (w0 + w1 + w2); w0 *= wi; w1 *= wi; w2 *= wi;
                    const u32x4 x0 = *(const u32x4*)(PB + (size_t)r * 512 + lane * 8), x1 = *(const u32x4*)(PB + ((size_t)MC + r) * 512 + lane * 8), x2 = *(const u32x4*)(PB + ((size_t)2 * MC + r) * 512 + lane * 8);
                    u32x4 ob;
#pragma unroll
                    for (int e = 0; e < 4; ++e) ob[e] = pk2(w0 * bflo(x0[e]) + w1 * bflo(x1[e]) + w2 * bflo(x2[e]), w0 * bfhi(x0[e]) + w1 * bfhi(x1[e]) + w2 * bfhi(x2[e]));
                    *(u32x4*)(OB + (size_t)r * 1536 + lane * 8) = ob;
                    const u32x4 c0 = *(const u32x4*)(XN + (size_t)r * 512 + lane * 8), c1 = *(const u32x4*)(XN + ((size_t)MC + r) * 512 + lane * 8);
                    float d[8]; float ss = 0.f;
#pragma unroll
                    for (int e = 0; e < 4; ++e) { d[2 * e] = bflo(c0[e]) - lam * bflo(c1[e]); d[2 * e + 1] = bfhi(c0[e]) - lam * bfhi(c1[e]); ss += d[2 * e] * d[2 * e] + d[2 * e + 1] * d[2 * e + 1]; }
                    ss += __shfl_xor(ss, 1); ss += __shfl_xor(ss, 2); ss += __shfl_xor(ss, 4); ss += __shfl_xor(ss, 8);
                    const float rs = osc / sqrtf(ss * (1.f / 128.f) + EPS);
                    u32x4 oc; oc.x = pk2(d[0] * rs * gs0[0], d[1] * rs * gs0[1]); oc.y = pk2(d[2] * rs * gs0[2], d[3] * rs * gs0[3]); oc.z = pk2(d[4] * rs * gs1[0], d[5] * rs * gs1[1]); oc.w = pk2(d[6] * rs * gs1[2], d[7] * rs * gs1[3]);
                    *(u32x4*)(OC + (size_t)r * 1536 + lane * 8) = oc;
                }
            }
            else if (kind == 4) {
                pg8::Gemm g{(const bf16_t*)(ws + WS_OA), (const bf16_t*)(ws + WS_WBR), MC, DM, 1536, 1536, 1536}; pg8::StaticOrder S; S.init(MC, DM, G, (int)blockIdx.x);
                EpiMerge E{ws, XN}; pg8::gemm_phase<EpiMerge, pg8::StaticOrder, true, true>(lds, g, S, E);
            }
            else if (kind == 5) {
                pg8::Gemm g{XN, (const bf16_t*)(ws + WS_WOUT), MC, DM, DM, DM, DM}; pg8::StaticOrder S; S.init(MC, DM, G, (int)blockIdx.x);
                EpiF32 E{ws}; pg8::gemm_phase<EpiF32, pg8::StaticOrder, true, true>(lds, g, S, E);
            }
            else if (kind == 6) {
                const float* xsrc = (l == 0 ? p.in[I_X] : p.out) + (size_t)tok0 * DM; float* xdst = p.out + (size_t)tok0 * DM;
                for (int r = gw; r < MC; r += NGW)
                    norm_row(xsrc + (size_t)r * DM, xdst + (size_t)r * DM, (const float*)(ws + WS_Y) + (size_t)r * DM, (const float*)(ws + WS_SSY) + r * 16, p.in[I_GMIXPOST] + l * DM, p.in[I_GMLPPRE] + l * DM, XN + (size_t)r * DM, lane);
            }
            else if (kind == 7) {
                pg8::Gemm g{XN, (const bf16_t*)(ws + WS_WUP), MC, FF, DM, DM, DM}; pg8::StaticOrder S; S.init(MC, FF, G, (int)blockIdx.x);
                EpiUp E{ws}; pg8::gemm_phase<EpiUp, pg8::StaticOrder, true, true>(lds, g, S, E);
            }
            else if (kind == 8) {
                pg8::Gemm g{(const bf16_t*)(ws + WS_U), (const bf16_t*)(ws + WS_WDN), MC, DM, FF, FF, FF}; pg8::StaticOrder S; S.init(MC, DM, G, (int)blockIdx.x);
                EpiF32 E{ws}; pg8::gemm_phase<EpiF32, pg8::StaticOrder, true, true>(lds, g, S, E);
            }
            else if (kind == 9) {
                float* xdst = p.out + (size_t)tok0 * DM; const bool lastl = l == DEPTH - 1;
                for (int r = gw; r < MC; r += NGW)
                    norm_row(xdst + (size_t)r * DM, xdst + (size_t)r * DM, (const float*)(ws + WS_Y) + (size_t)r * DM, (const float*)(ws + WS_SSY) + r * 16, p.in[I_GMLPPOST] + l * DM,
                             lastl ? nullptr : p.in[I_GMIXPRE] + (l + 1) * DM, lastl ? nullptr : XN + (size_t)r * DM, lane);
                if (c == NCHUNK - 1 && !lastl) { __syncthreads(); convert_layer(p, l + 1, lds, gw, NGW, wave, lane); }
            }
    }
    if (ph + 1 < p.ph_hi) {
        if (ph == 0) { grid.sync(); xbar = xcd_barrier_post((unsigned*)p.ws, xst); }
        else xcd_barrier(xbar);
    }
    }
}

constexpr int N_PHASES = 1 + DEPTH * NCHUNK * 10;
extern "C" void kernel_launch(void* const* d_in, const int* in_sizes, int n_in, void* d_out, int out_size, void* d_ws, size_t ws_size, hipStream_t stream) {
    static int grid = 0;
    if (grid == 0) {
        if (n_in != 21 || out_size != MALL * DM || ws_size < WS_END) { fprintf(stderr, "kernel_launch: unexpected shapes (n_in %d out %d ws %zu)\n", n_in, out_size, ws_size); grid = -1; return; }
        int dev = 0, cus = 0, per_cu = 0;
        (void)hipGetDevice(&dev); (void)hipDeviceGetAttribute(&cus, hipDeviceAttributeMultiprocessorCount, dev);
        (void)hipFuncSetAttribute((const void*)fwd_megakernel, hipFuncAttributeMaxDynamicSharedMemorySize, LDS_BYTES);
        (void)hipOccupancyMaxActiveBlocksPerMultiprocessor(&per_cu, (const void*)fwd_megakernel, 512, LDS_BYTES);
        if (per_cu < 1) per_cu = 1;
        grid = cus * per_cu;
    }
    if (grid < 0) return;
    Params p{};
    for (int i = 0; i < 21; ++i) p.in[i] = (const float*)d_in[i];
    p.out = (float*)d_out; p.ws = (unsigned char*)d_ws;
    for (int i = 0; i < 16; ++i) p.inv[i] = pow(10000.0, -(double)i / 16.0);
    for (int l = 0; l < 4; ++l) p.lam_init[l] = (float)(0.8 - 0.6 * exp(-0.3 * (double)l));
    p.ph_lo = 0; p.ph_hi = N_PHASES;
    void* args[] = {&p};
    hipError_t e = hipLaunchCooperativeKernel((const void*)fwd_megakernel, dim3(grid), dim3(512), args, LDS_BYTES, stream);
    if (e != hipSuccess) fprintf(stderr, "cooperative launch failed: %s (grid %d)\n", hipGetErrorString(e), grid);
}
```
